# Optimizing an MI355X kernel written in HIP

```python
import math
import jax, jax.numpy as jnp
from jax import lax
import numpy as np

D_MODEL = 1024
BATCH = 8
SEQ = 2048
DEPTH = 1

CHUNK = 64
N_META = 16
Q_BLOCK = 128
D_MIX = D_MODEL
ATTN_WIDTH = D_MIX // 2
RWKV_WIDTH = D_MIX - ATTN_WIDTH
DA_HEAD_DIM = 64
DA_HEADS = ATTN_WIDTH // (2 * DA_HEAD_DIM)
RW_HEAD_DIM = 64
RW_HEADS = RWKV_WIDTH // RW_HEAD_DIM
W_LORA = 64
A_LORA = 64
G_LORA = 128
ATTN_COLS = 3 * ATTN_WIDTH
RW_COLS = 3 * RWKV_WIDTH + W_LORA + A_LORA + G_LORA
IN_COLS = ATTN_COLS + RW_COLS
D_FF = ((8 * D_MODEL // 3 + 255) // 256) * 256
RMS_EPS = 1e-6
GN_EPS = 64e-5

kernel_name = "hymba_diffattn_rwkv7_macaron_block"


def rms_norm(x, g):
    xf = x.astype(jnp.float32)
    y = xf * lax.rsqrt(jnp.mean(xf * xf, axis=-1, keepdims=True) + RMS_EPS)
    return (y * g.astype(jnp.float32)).astype(x.dtype)


def swiglu(x, w_gate, w_up, w_down):
    return (jax.nn.silu(x @ w_gate) * (x @ w_up)) @ w_down


def token_shift(x):
    return jnp.pad(x, ((0, 0), (1, 0), (0, 0)))[:, :-1]


def chunk_index(pos):
    return (pos - N_META) // CHUNK


def alibi_slopes(n_heads):
    return 2.0 ** (-8.0 * (jnp.arange(n_heads, dtype=jnp.float32) + 1.0) / n_heads)


def _diff_attn_block(q, qpos, k, v, kpos, slopes, lam):
    scale = DA_HEAD_DIM ** -0.5
    s = jnp.einsum('bqhcd,bkhcd->bhcqk', q, k).astype(jnp.float32) * scale
    dist = jnp.abs(qpos[:, None] - kpos[None, :]).astype(jnp.float32)
    s = s - slopes[None, :, None, None, None] * dist[None, None, None]
    visible = chunk_index(kpos)[None, :] <= chunk_index(qpos)[:, None]
    s = jnp.where(visible[None, None, None], s, -jnp.inf)
    p = jax.nn.softmax(s, axis=-1)
    attn = p[:, :, 0] - lam * p[:, :, 1]
    return jnp.einsum('bhqk,bkhe->bqhe', attn.astype(v.dtype), v)


def diff_attention_mixer(p, pos, slopes, q_gain, k_gain, lambda_vecs, out_gain, lam_init):
    B, L, _ = p.shape
    q, k, v = jnp.split(p, 3, axis=-1)
    q = rms_norm(q.reshape(B, L, DA_HEADS, 2, DA_HEAD_DIM), q_gain)
    k = rms_norm(k.reshape(B, L, DA_HEADS, 2, DA_HEAD_DIM), k_gain)
    v = v.reshape(B, L, DA_HEADS, 2 * DA_HEAD_DIM)
    lv = lambda_vecs.astype(jnp.float32)
    lam = jnp.exp(jnp.sum(lv[0] * lv[1])) - jnp.exp(jnp.sum(lv[2] * lv[3])) + lam_init

    def attend(qb, qpos):
        return _diff_attn_block(qb, qpos, k, v, pos, slopes, lam)

    y_meta = attend(q[:, :N_META], pos[:N_META])
    nb = (L - N_META) // Q_BLOCK
    qb = jnp.swapaxes(q[:, N_META:].reshape(B, nb, Q_BLOCK, DA_HEADS, 2, DA_HEAD_DIM), 0, 1)
    pb = pos[N_META:].reshape(nb, Q_BLOCK)
    y = lax.map(lambda args: attend(args[0], args[1]), (qb, pb))
    y = jnp.swapaxes(y, 0, 1).reshape(B, L - N_META, DA_HEADS, 2 * DA_HEAD_DIM)
    y = jnp.concatenate([y_meta, y], axis=1)
    y = rms_norm(y, out_gain) * (1.0 - lam_init)
    return y.reshape(B, L, ATTN_WIDTH)


def _heads(t):
    return t.reshape(t.shape[:-1] + (RW_HEADS, RW_HEAD_DIM))


def _rwkv7_scan(r, w, k, v, a, b):
    B, L, H, N = r.shape

    def step(S, inp):
        r_t, w_t, k_t, v_t, a_t, b_t = inp
        sa = jnp.einsum('bhij,bhj->bhi', S, a_t)
        S = (S * w_t[:, :, None, :] + sa[..., None] * b_t[:, :, None, :]
             + v_t[..., None] * k_t[:, :, None, :])
        return S, jnp.einsum('bhij,bhj->bhi', S, r_t)

    xs = tuple(jnp.swapaxes(t, 0, 1) for t in (r, w, k, v, a, b))
    _, y = lax.scan(step, jnp.zeros((B, H, N, N), jnp.float32), xs)
    return jnp.swapaxes(y, 0, 1)


def rwkv7_mixer(p, mu, w0, w_up, a0, a_up, g_up, k_k, k_a, r_k, ln_w, ln_b):
    B, L, _ = p.shape
    p = p + (token_shift(p) - p) * mu
    splits = [RWKV_WIDTH, 2 * RWKV_WIDTH, 3 * RWKV_WIDTH,
              3 * RWKV_WIDTH + W_LORA, 3 * RWKV_WIDTH + W_LORA + A_LORA]
    r, k, v, xw, xa, xg = jnp.split(p, splits, axis=-1)
    w_log = -jax.nn.softplus(-(w0 + jnp.tanh(xw) @ w_up).astype(jnp.float32)) - 0.5
    decay = jnp.exp(-jnp.exp(w_log))
    a = _heads(jax.nn.sigmoid((a0 + xa @ a_up).astype(jnp.float32)))
    g = jax.nn.sigmoid(xg) @ g_up
    kk = _heads((k * k_k).astype(jnp.float32))
    kk = kk / jnp.maximum(jnp.sqrt(jnp.sum(kk * kk, axis=-1, keepdims=True)), 1e-12)
    k_h = _heads(k.astype(jnp.float32)) * (1.0 + (a - 1.0) * _heads(k_a.astype(jnp.float32)))
    r_h = _heads(r.astype(jnp.float32))
    v_h = _heads(v.astype(jnp.float32))
    y = _rwkv7_scan(r_h, _heads(decay), k_h, v_h, -kk, kk * a)
    mean = jnp.mean(y, axis=-1, keepdims=True)
    var = jnp.mean(jnp.square(y - mean), axis=-1, keepdims=True)
    y = (y - mean) * lax.rsqrt(var + GN_EPS) * _heads(ln_w.astype(jnp.float32)) \
        + _heads(ln_b.astype(jnp.float32))
    y = y + jnp.sum(r_h * k_h * r_k.astype(jnp.float32), axis=-1, keepdims=True) * v_h
    return (y.reshape(B, L, RWKV_WIDTH) * g).astype(p.dtype)


def setup_inputs(seed: int = 0) -> dict:
    key = jax.random.key(seed)
    ks = jax.random.split(key, 28)
    f32 = jnp.float32

    def nrm(k, shape, scale):
        return jax.random.normal(k, shape, f32) * scale

    def gain(k, shape):
        return 1.0 + 0.02 * jax.random.normal(k, shape, f32)

    return {
        "x": nrm(ks[0], (BATCH, SEQ, D_MODEL), 1.0),
        "meta_tokens": nrm(ks[1], (N_META, D_MODEL), 1.0),
        "ffn1_norm": gain(ks[2], (DEPTH, D_MODEL)),
        "ffn1_gate": nrm(ks[3], (DEPTH, D_MODEL, D_FF), D_MODEL ** -0.5),
        "ffn1_up": nrm(ks[4], (DEPTH, D_MODEL, D_FF), D_MODEL ** -0.5),
        "ffn1_down": nrm(ks[5], (DEPTH, D_FF, D_MODEL), D_FF ** -0.5),
        "mix_norm": gain(ks[6], (DEPTH, D_MODEL)),
        "w_in": nrm(ks[7], (DEPTH, D_MODEL, IN_COLS), D_MODEL ** -0.5),
        "q_norm": gain(ks[8], (DEPTH, DA_HEAD_DIM)),
        "k_norm": gain(ks[9], (DEPTH, DA_HEAD_DIM)),
        "lambda_vecs": nrm(ks[10], (DEPTH, 4, DA_HEAD_DIM), 0.1),
        "attn_out_norm": gain(ks[11], (DEPTH, 2 * DA_HEAD_DIM)),
        "rw_mu": jax.random.uniform(ks[12], (DEPTH, RW_COLS), f32),
        "rw_w0": jax.random.uniform(ks[13], (DEPTH, RWKV_WIDTH), f32, minval=-5.0, maxval=-1.0),
        "rw_w_up": nrm(ks[14], (DEPTH, W_LORA, RWKV_WIDTH), 0.1),
        "rw_a0": nrm(ks[15], (DEPTH, RWKV_WIDTH), 0.1),
        "rw_a_up": nrm(ks[16], (DEPTH, A_LORA, RWKV_WIDTH), A_LORA ** -0.5),
        "rw_g_up": nrm(ks[17], (DEPTH, G_LORA, RWKV_WIDTH), G_LORA ** -0.5),
        "rw_k_k": 0.85 + nrm(ks[18], (DEPTH, RWKV_WIDTH), 0.05),
        "rw_k_a": 1.0 + nrm(ks[19], (DEPTH, RWKV_WIDTH), 0.05),
        "rw_r_k": nrm(ks[20], (DEPTH, RW_HEADS, RW_HEAD_DIM), 0.1),
        "rw_ln_w": gain(ks[21], (DEPTH, RWKV_WIDTH)),
        "rw_ln_b": nrm(ks[22], (DEPTH, RWKV_WIDTH), 0.02),
        "w_out": nrm(ks[23], (DEPTH, D_MIX, D_MODEL), D_MIX ** -0.5),
        "ffn2_norm": gain(ks[24], (DEPTH, D_MODEL)),
        "ffn2_gate": nrm(ks[25], (DEPTH, D_MODEL, D_FF), D_MODEL ** -0.5),
        "ffn2_up": nrm(ks[26], (DEPTH, D_MODEL, D_FF), D_MODEL ** -0.5),
        "ffn2_down": nrm(ks[27], (DEPTH, D_FF, D_MODEL), D_FF ** -0.5),
    }


def reference(x, meta_tokens, ffn1_norm, ffn1_gate, ffn1_up, ffn1_down, mix_norm, w_in,
              q_norm, k_norm, lambda_vecs, attn_out_norm, rw_mu, rw_w0, rw_w_up, rw_a0,
              rw_a_up, rw_g_up, rw_k_k, rw_k_a, rw_r_k, rw_ln_w, rw_ln_b, w_out,
              ffn2_norm, ffn2_gate, ffn2_up, ffn2_down):
    B = x.shape[0]
    meta = jnp.broadcast_to(meta_tokens[None].astype(x.dtype), (B, N_META, D_MODEL))
    h = jnp.concatenate([meta, x], axis=1)
    L = h.shape[1]
    pos = jnp.arange(L, dtype=jnp.int32)
    slopes = alibi_slopes(DA_HEADS)
    for l in range(DEPTH):
        lam_init = 0.8 - 0.6 * math.exp(-0.3 * l)
        h = h + 0.5 * swiglu(rms_norm(h, ffn1_norm[l]), ffn1_gate[l], ffn1_up[l], ffn1_down[l])
        u = rms_norm(h, mix_norm[l])
        proj = u @ w_in[l]
        y_attn = diff_attention_mixer(proj[..., :ATTN_COLS], pos, slopes, q_norm[l], k_norm[l],
                                      lambda_vecs[l], attn_out_norm[l], lam_init)
        y_rwkv = rwkv7_mixer(proj[..., ATTN_COLS:], rw_mu[l], rw_w0[l], rw_w_up[l], rw_a0[l],
                             rw_a_up[l], rw_g_up[l], rw_k_k[l], rw_k_a[l], rw_r_k[l],
                             rw_ln_w[l], rw_ln_b[l])
        h = h + jnp.concatenate([y_attn, y_rwkv], axis=-1) @ w_out[l]
        h = h + 0.5 * swiglu(rms_norm(h, ffn2_norm[l]), ffn2_gate[l], ffn2_up[l], ffn2_down[l])
    return h[:, N_META:]
```

```cpp
#include <hip/hip_runtime.h>
#include <hip/hip_cooperative_groups.h>
#include <cstdio>
#include <cstdint>
namespace cg = cooperative_groups;
namespace pg8 {
#define PG8_LAS __attribute__((address_space(3)))
typedef unsigned short bf16_t;
typedef short bf16x8 __attribute__((ext_vector_type(8)));
typedef float f32x4 __attribute__((ext_vector_type(4)));
typedef unsigned u32x4 __attribute__((ext_vector_type(4)));
constexpr int BM = 256, BK = 64, HALF = 128, HTB = HALF * BK * 2  , STAGE_BYTES = 8 * HTB, NXCD = 8, WGM = 8;

__host__ __device__ __forceinline__ int lds_byte(int r, int c) { const int st = (r >> 4) * 2 + (c >> 5), rr = r & 15, cc = c & 31, ob = rr * 64 + cc * 2; return st * 1024 + (ob ^ (((ob >> 9) & 1) << 5)); }
__host__ __device__ __forceinline__ void stage_rc(int b, int& R, int& C) { const int st = b / 1024, sb = b % 1024, swz = sb ^ (((sb >> 9) & 1) << 5); R = (st >> 1) * 16 + swz / 64; C = (st & 1) * 32 + (swz % 64) / 2; }
__host__ __device__ __forceinline__ int perm32(int rho) { const int n = rho >> 4, i = rho & 15; return 8 * (i >> 2) + 4 * n + (i & 3); }

struct Unit { int pm, pn; };
struct Gemm { const bf16_t* A; const bf16_t* Bt; int M, N, K; };

struct StaticOrder {
    int nM, nN, nwg, G, c;
    __host__ __device__ void init(int M, int N, int G_, int c_) { nM = M / BM; nN = N / BM; nwg = nM * nN; G = G_; c = c_; }
    __host__ __device__ bool next(int i, Unit& u) const {
        const long L = (long)i * G + c; if (L >= nwg) return false;
        int wgid = (int)L; { const int q = nwg / NXCD, r = nwg % NXCD, xcd = wgid % NXCD, off = wgid / NXCD; wgid = (xcd < r ? xcd * (q + 1) : r * (q + 1) + (xcd - r) * q) + off; }
        const int nig = WGM * nN, gid = wgid / nig, fm = gid * WGM, gsz = (nM - fm) < WGM ? (nM - fm) : WGM;
        u.pm = fm + ((wgid % nig) % gsz); u.pn = (wgid % nig) / gsz; return true;
    }
    __device__ __forceinline__ void a_ready(const Unit&) const {}
    __device__ __forceinline__ void done(const Unit&) const {}
};

typedef __bf16 bf16x2_t __attribute__((ext_vector_type(2)));
typedef float f32x2_t __attribute__((ext_vector_type(2)));
__device__ __forceinline__ unsigned cvt_pk_bf16(float lo, float hi) { f32x2_t v = {lo, hi}; bf16x2_t b = __builtin_convertvector(v, bf16x2_t); return __builtin_bit_cast(unsigned, b); }
typedef float f32x2 __attribute__((ext_vector_type(2)));
typedef unsigned u32x2 __attribute__((ext_vector_type(2)));
__device__ __forceinline__ float silu_f(float g) { return g * __builtin_amdgcn_rcpf(1.0f + __builtin_amdgcn_exp2f(-1.44269504f * g)); }
struct EpiSwiGLU {
    static constexpr bool PERM = true, AFTER_DRAIN = false;
    bf16_t* O; int ldc; const float* rowss;
    __device__ __forceinline__ void operator()(const f32x4 (&acc)[2][2][4][2], const Unit& u, int wr, int wc, int fr, int fq) const {
        const int row0 = u.pm * BM + wr * 64 + fr, col0 = u.pn * HALF + wc * 32 + 8 * fq;
#pragma unroll
        for (int ai = 0; ai < 2; ++ai)
#pragma unroll
            for (int m = 0; m < 4; ++m) {
                const int row = row0 + ai * HALF + m * 16;
                const float rs = rowss ? __builtin_amdgcn_rsqf(rowss[row] * (1.0f / 1024.0f) + 1e-6f) : 1.0f;
                bf16_t* rowp = O + (size_t)row * ldc + col0;
                const f32x4 g0 = acc[ai][0][m][0] * rs, g1 = acc[ai][0][m][1] * rs, u0 = acc[ai][1][m][0] * rs, u1 = acc[ai][1][m][1] * rs;
                u32x4 w;
                w.x = cvt_pk_bf16(silu_f(g0[0]) * u0[0], silu_f(g0[1]) * u0[1]); w.y = cvt_pk_bf16(silu_f(g0[2]) * u0[2], silu_f(g0[3]) * u0[3]);
                w.z = cvt_pk_bf16(silu_f(g1[0]) * u1[0], silu_f(g1[1]) * u1[1]); w.w = cvt_pk_bf16(silu_f(g1[2]) * u1[2], silu_f(g1[3]) * u1[3]);
                *(u32x4*)rowp = w;
            }
    }
};
struct EpiResid {
    static constexpr bool PERM = true, AFTER_DRAIN = false;
    const float* basef; const bf16_t* baseh; const float* brow; float* out; bf16_t* hb; float* rowss; float scale;
    __device__ __forceinline__ void operator()(const f32x4 (&acc)[2][2][4][2], const Unit& u, int wr, int wc, int fr, int fq) const {
        const int col0 = u.pn * BM + wc * 32 + 8 * fq;
#pragma unroll
        for (int ai = 0; ai < 2; ++ai)
#pragma unroll
            for (int m = 0; m < 4; ++m) {
                const int row = u.pm * BM + ai * HALF + wr * 64 + m * 16 + fr; float ss = 0.f; const float bsc = brow ? brow[row] : 1.0f;
#pragma unroll
                for (int bj = 0; bj < 2; ++bj) { const size_t off = (size_t)row * 1024 + col0 + bj * HALF;
                    f32x4 b0, b1;
                    if (basef) { b0 = *(const f32x4*)(basef + off); b1 = *(const f32x4*)(basef + off + 4); }
                    else { const u32x4 r = *(const u32x4*)(baseh + off);
                        b0 = (f32x4){__uint_as_float(r.x << 16), __uint_as_float(r.x & 0xffff0000u), __uint_as_float(r.y << 16), __uint_as_float(r.y & 0xffff0000u)} * bsc;
                        b1 = (f32x4){__uint_as_float(r.z << 16), __uint_as_float(r.z & 0xffff0000u), __uint_as_float(r.w << 16), __uint_as_float(r.w & 0xffff0000u)} * bsc; }
                    const f32x4 o0 = b0 + acc[ai][bj][m][0] * scale, o1 = b1 + acc[ai][bj][m][1] * scale;
                    if (out) { __builtin_nontemporal_store(o0, (f32x4*)(out + off)); __builtin_nontemporal_store(o1, (f32x4*)(out + off + 4)); }
                    if (hb) { u32x4 w; w.x = cvt_pk_bf16(o0[0], o0[1]); w.y = cvt_pk_bf16(o0[2], o0[3]); w.z = cvt_pk_bf16(o1[0], o1[1]); w.w = cvt_pk_bf16(o1[2], o1[3]); *(u32x4*)(hb + off) = w;
                        ss += ((o0[0] * o0[0] + o0[1] * o0[1]) + (o0[2] * o0[2] + o0[3] * o0[3])) + ((o1[0] * o1[0] + o1[1] * o1[1]) + (o1[2] * o1[2] + o1[3] * o1[3])); } }
                if (hb) { ss += __shfl_xor(ss, 16); ss += __shfl_xor(ss, 32); if (fq == 0) atomicAdd(rowss + row, ss); }
            }
    }
};
struct EpiProj {
    static constexpr bool PERM = true, AFTER_DRAIN = false;
    bf16_t* P; size_t piece_elems; const float* rowss;
    __device__ __forceinline__ void operator()(const f32x4 (&acc)[2][2][4][2], const Unit& u, int wr, int wc, int fr, int fq) const {
        const int c0 = u.pn * BM; const int t = c0 >= 3072 ? 6 : (c0 >> 9); const int ld = (t == 6) ? 256 : 512; const int colt = c0 - (t == 6 ? 3072 : (t << 9));
        bf16_t* base = P + (size_t)t * piece_elems; const int row0 = u.pm * BM + wr * 64 + fr, col0 = colt + wc * 32 + 8 * fq;
#pragma unroll
        for (int ai = 0; ai < 2; ++ai)
#pragma unroll
            for (int m = 0; m < 4; ++m) { const int row = row0 + ai * HALF + m * 16; bf16_t* rowp = base + (size_t)row * ld + col0;
                const float rs = __builtin_amdgcn_rsqf(rowss[row] * (1.0f / 1024.0f) + 1e-6f);
#pragma unroll
                for (int bj = 0; bj < 2; ++bj) { const f32x4 v0 = acc[ai][bj][m][0] * rs, v1 = acc[ai][bj][m][1] * rs; u32x4 w;
                    w.x = cvt_pk_bf16(v0[0], v0[1]); w.y = cvt_pk_bf16(v0[2], v0[3]); w.z = cvt_pk_bf16(v1[0], v1[1]); w.w = cvt_pk_bf16(v1[2], v1[3]);
                    *(u32x4*)(rowp + bj * HALF) = w; } }
    }
};
template <class Epi, class Sched, bool ALIGN_EPI = false, bool SP2 = false>
__device__ __forceinline__ void gemm_phase(PG8_LAS unsigned char* lds, const Gemm g, const Sched& S, const Epi& E) {
    const int tid = threadIdx.x, wid = __builtin_amdgcn_readfirstlane(tid >> 6), lane = tid & 63, wr = wid >> 2, wc = wid & 3, fr = lane & 15, fq = lane >> 4;
    const int K = g.K, nt = K / BK;
    unsigned voffA[2], voffB[2];
#pragma unroll
    for (int i = 0; i < 2; ++i) { int R, C; stage_rc(tid * 16 + i * 8192, R, C); const int Rb = Epi::PERM ? ((R & ~31) + perm32(R & 31)) : R;
        voffA[i] = (unsigned)(R * K + C) * 2u; voffB[i] = (unsigned)(Rb * K + C) * 2u; }
    const size_t kstep = (size_t)(BK * 2);
    const size_t hstep = (size_t)HALF * K * 2;
    const size_t tstep = 2 * hstep;
    const unsigned ldsw = (unsigned)wid * 1024u;
    const int aoff = lds_byte(wr * 64 + fr, fq * 8), boff = lds_byte(wc * 32 + fr, fq * 8);
#define PG8_SA(b, h) (((b) * 2 + (h)) * HTB)
#define PG8_SB(b, h) ((4 + (b) * 2 + (h)) * HTB)
#define PG8_STAGE(bufoff, gbase, voff) do { _Pragma("unroll") for (int _i = 0; _i < 2; ++_i) \
        __builtin_amdgcn_global_load_lds((const unsigned*)((const char*)(gbase) + (voff)[_i]), (PG8_LAS unsigned*)(lds + (bufoff) + ldsw + _i * 8192), 16, 0, 0); } while (0)
#define PG8_LDA(dst, b, h) do { _Pragma("unroll") for (int m = 0; m < 4; ++m) _Pragma("unroll") for (int k = 0; k < 2; ++k) dst[m][k] = *(const PG8_LAS bf16x8*)(lds + PG8_SA(b, h) + aoff + m * 2048 + k * 1024); } while (0)
#define PG8_LDB(dst, b, h) do { _Pragma("unroll") for (int n = 0; n < 2; ++n) _Pragma("unroll") for (int k = 0; k < 2; ++k) dst[n][k] = *(const PG8_LAS bf16x8*)(lds + PG8_SB(b, h) + boff + n * 2048 + k * 1024); } while (0)
#define PG8_MMA(ai, bj, At, Bt) do { __builtin_amdgcn_s_setprio(1); _Pragma("unroll") for (int m = 0; m < 4; ++m) _Pragma("unroll") for (int n = 0; n < 2; ++n) _Pragma("unroll") for (int k = 0; k < 2; ++k) \
        acc[ai][bj][m][n] = __builtin_amdgcn_mfma_f32_16x16x32_bf16(Bt[n][k], At[m][k], acc[ai][bj][m][n], 0, 0, 0); __builtin_amdgcn_s_setprio(0); } while (0)
#define PG8_WAIT_V(n) asm volatile("s_waitcnt vmcnt(" #n ")" ::: "memory")
#define PG8_WAIT_L(n) asm volatile("s_waitcnt lgkmcnt(" #n ")" ::: "memory")
#define PG8_BAR __builtin_amdgcn_s_barrier()
#define PG8_SCHED __builtin_amdgcn_sched_barrier(0)
    Unit cur, nxt; int ui = 0;
    if (!S.next(0, cur)) return;
    f32x4 acc[2][2][4][2];
#pragma unroll
    for (int a = 0; a < 2; ++a)
#pragma unroll
        for (int b = 0; b < 2; ++b)
#pragma unroll
            for (int m = 0; m < 4; ++m)
#pragma unroll
                for (int n = 0; n < 2; ++n) acc[a][b][m][n] = (f32x4){0.f, 0.f, 0.f, 0.f};
    bf16x8 At[4][2], B0[2][2], B1[2][2];
    const char* cA = (const char*)g.A + (size_t)cur.pm * tstep; const char* cB = (const char*)g.Bt + (size_t)cur.pn * tstep;
    S.a_ready(cur);
    if constexpr (SP2) {
        PG8_STAGE(PG8_SB(0, 0), cB, voffB); PG8_STAGE(PG8_SB(0, 1), cB + hstep, voffB); PG8_STAGE(PG8_SA(0, 0), cA, voffA); PG8_STAGE(PG8_SA(0, 1), cA + hstep, voffA);
        if (wr == 1) PG8_BAR;
        PG8_WAIT_V(2); PG8_BAR;
        PG8_STAGE(PG8_SB(1, 0), cB + kstep, voffB); PG8_STAGE(PG8_SA(1, 0), cA + kstep, voffA); PG8_STAGE(PG8_SB(1, 1), cB + hstep + kstep, voffB);
        PG8_WAIT_V(6); PG8_BAR;
    } else {
        PG8_STAGE(PG8_SB(0, 0), cB, voffB); PG8_STAGE(PG8_SA(0, 0), cA, voffA); PG8_STAGE(PG8_SB(0, 1), cB + hstep, voffB); PG8_STAGE(PG8_SA(0, 1), cA + hstep, voffA);
        if (wr == 1) PG8_BAR;
        PG8_WAIT_V(4); PG8_BAR;
        PG8_STAGE(PG8_SB(1, 0), cB + kstep, voffB); PG8_STAGE(PG8_SA(1, 0), cA + kstep, voffA); PG8_STAGE(PG8_SB(1, 1), cB + hstep + kstep, voffB);
        PG8_WAIT_V(6); PG8_BAR;
    }
    for (;;) {
        const bool has_next = S.next(ui + 1, nxt);
        const char* nA = has_next ? (const char*)g.A + (size_t)nxt.pm * tstep : cA; const char* nB = has_next ? (const char*)g.Bt + (size_t)nxt.pn * tstep : cB;
        for (int t = 0; t < nt; t += 2) {
            const bool last = (t == nt - 2);
            const char* a1 = cA + (size_t)(t + 1) * kstep;
            const char* a2 = last ? nA : cA + (size_t)(t + 2) * kstep; const char* b2 = last ? nB : cB + (size_t)(t + 2) * kstep;
            const char* a3 = a2 + kstep; const char* b3 = b2 + kstep;
            if (last && has_next) S.a_ready(nxt);
            if constexpr (SP2) {
            PG8_LDB(B0, 0, 0); PG8_LDB(B1, 0, 1); PG8_SCHED; PG8_LDA(At, 0, 0); PG8_STAGE(PG8_SA(1, 1), a1 + hstep, voffA);
            PG8_WAIT_V(8); PG8_WAIT_L(0); PG8_BAR; PG8_MMA(0, 0, At, B0); PG8_MMA(0, 1, At, B1); PG8_BAR; PG8_SCHED;
            PG8_LDA(At, 0, 1); PG8_STAGE(PG8_SB(0, 0), b2, voffB); PG8_STAGE(PG8_SB(0, 1), b2 + hstep, voffB); PG8_STAGE(PG8_SA(0, 0), a2, voffA);
            PG8_WAIT_V(8); PG8_WAIT_L(0); PG8_BAR; PG8_MMA(1, 0, At, B0); PG8_MMA(1, 1, At, B1); PG8_BAR; PG8_SCHED;
            PG8_LDB(B0, 1, 0); PG8_LDB(B1, 1, 1); PG8_SCHED; PG8_LDA(At, 1, 0); PG8_STAGE(PG8_SA(0, 1), a2 + hstep, voffA);
            PG8_WAIT_V(8); PG8_WAIT_L(0); PG8_BAR; PG8_MMA(0, 0, At, B0); PG8_MMA(0, 1, At, B1); PG8_BAR; PG8_SCHED;
            PG8_LDA(At, 1, 1); PG8_STAGE(PG8_SB(1, 0), b3, voffB); PG8_STAGE(PG8_SB(1, 1), b3 + hstep, voffB); PG8_STAGE(PG8_SA(1, 0), a3, voffA);
            PG8_WAIT_V(8); PG8_WAIT_L(0); PG8_BAR; PG8_MMA(1, 0, At, B0); PG8_MMA(1, 1, At, B1); PG8_BAR; PG8_SCHED;
            } else {
            PG8_LDB(B0, 0, 0); PG8_SCHED; PG8_LDA(At, 0, 0); PG8_STAGE(PG8_SA(1, 1), a1 + hstep, voffA);
            PG8_WAIT_L(8); PG8_BAR; PG8_WAIT_L(0); PG8_MMA(0, 0, At, B0); PG8_BAR; PG8_SCHED;
            PG8_LDB(B1, 0, 1); PG8_STAGE(PG8_SB(0, 0), b2, voffB);
            PG8_BAR; PG8_WAIT_L(0); PG8_MMA(0, 1, At, B1); PG8_BAR;
            PG8_LDA(At, 0, 1); PG8_STAGE(PG8_SA(0, 0), a2, voffA);
            PG8_BAR; PG8_WAIT_L(0); PG8_MMA(1, 0, At, B0); PG8_BAR; PG8_SCHED;
            PG8_STAGE(PG8_SB(0, 1), b2 + hstep, voffB);
            PG8_WAIT_V(6); PG8_BAR; PG8_MMA(1, 1, At, B1); PG8_BAR;
            PG8_LDB(B0, 1, 0); PG8_SCHED; PG8_LDA(At, 1, 0); PG8_STAGE(PG8_SA(0, 1), a2 + hstep, voffA);
            PG8_WAIT_L(8); PG8_BAR; PG8_WAIT_L(0); PG8_MMA(0, 0, At, B0); PG8_BAR; PG8_SCHED;
            PG8_LDB(B1, 1, 1); PG8_STAGE(PG8_SB(1, 0), b3, voffB);
            PG8_BAR; PG8_WAIT_L(0); PG8_MMA(0, 1, At, B1); PG8_BAR;
            PG8_LDA(At, 1, 1); PG8_STAGE(PG8_SA(1, 0), a3, voffA);
            PG8_BAR; PG8_WAIT_L(0); PG8_MMA(1, 0, At, B0); PG8_BAR; PG8_SCHED;
            PG8_STAGE(PG8_SB(1, 1), b3 + hstep, voffB);
            PG8_WAIT_V(6); PG8_BAR; PG8_MMA(1, 1, At, B1); PG8_BAR;
            }
        }
        if constexpr (ALIGN_EPI) { if (wr == 0) PG8_BAR; }
        if constexpr (!Epi::AFTER_DRAIN) { E(acc, cur, wr, wc, fr, fq); S.done(cur); }
        if (!has_next) break;
#pragma unroll
        for (int a = 0; a < 2; ++a)
#pragma unroll
            for (int b = 0; b < 2; ++b)
#pragma unroll
                for (int m = 0; m < 4; ++m)
#pragma unroll
                    for (int n = 0; n < 2; ++n) acc[a][b][m][n] = (f32x4){0.f, 0.f, 0.f, 0.f};
        cur = nxt; cA = nA; cB = nB; ++ui;
        if constexpr (ALIGN_EPI) { if (wr == 1) PG8_BAR; }
    }
    PG8_WAIT_V(0);
    if constexpr (!ALIGN_EPI) { if (wr == 0) PG8_BAR; }
    PG8_BAR;
    if constexpr (Epi::AFTER_DRAIN) { E.fused(acc, cur, wr, wc, fr, fq, lds, wid, lane); S.done(cur); }
#undef PG8_SA
#undef PG8_SB
#undef PG8_STAGE
#undef PG8_LDA
#undef PG8_LDB
#undef PG8_MMA
#undef PG8_WAIT_V
#undef PG8_WAIT_L
#undef PG8_BAR
#undef PG8_SCHED
}
}
#define LAS __attribute__((address_space(3)))
typedef unsigned short bf16;
typedef short bf16x8 __attribute__((ext_vector_type(8)));
typedef float f32x4 __attribute__((ext_vector_type(4)));
typedef unsigned u32x4 __attribute__((ext_vector_type(4)));
typedef unsigned u32x2 __attribute__((ext_vector_type(2)));
typedef _Float16 h16;
typedef _Float16 h16x4 __attribute__((ext_vector_type(4)));
#define LDS_WAIT() asm volatile("s_waitcnt lgkmcnt(0)" ::: "memory")

constexpr int DM = 1024, NBATCH = 8, SEQ = 2048, NMETA = 16, LPOS = 2064, DFF = 2816, INC = 3328;
constexpr int MMAIN = 16384, MALL = 16640, MVALID = 16400;
constexpr int NWAVES = 8, NTHREADS = 512;
constexpr int LDS_BYTES = 135168;
constexpr size_t OFF_WGU1 = 0, OFF_WD1 = 11534336, OFF_WIN = 17301504, OFF_WOUT = 24117248, OFF_WGU2 = 26214400, OFF_WD2 = 37748736;
constexpr size_t OFF_LW = 43515904, OFF_LA = 43581440, OFF_LG = 43646976, OFF_HM = 43778048, OFF_BONUS = 44826624;
constexpr size_t OFF_SS1 = 45359104, OFF_SS2 = OFF_SS1 + 16640 * 4;
constexpr size_t OFF_BAR = OFF_SS2 + 16640 * 4;
constexpr size_t OFF_RMS0 = OFF_BAR + 3456 * 4;
static_assert(OFF_BAR % 256 == 0 && OFF_RMS0 % 256 == 0 && OFF_RMS0 + 16640 * 4 <= 46137344, "ws map 0");
constexpr size_t OFF_RA = 46137344, OFF_RB = 80740352, OFF_RC = 191889408, WS_END = 260046848;
constexpr size_t PIECE_B = 17039360, PIECE_E = PIECE_B / 2;
constexpr size_t OFF_PQ = OFF_RB, OFF_PK = OFF_RB + PIECE_B, OFF_PV = OFF_RB + 2 * PIECE_B, OFF_PR = OFF_RB + 3 * PIECE_B, OFF_PKR = OFF_RB + 4 * PIECE_B, OFF_PVR = OFF_RB + 5 * PIECE_B, OFF_PX = OFF_RB + 6 * PIECE_B;
constexpr size_t OFF_ACT = OFF_RB, OFF_VT = OFF_RC;
constexpr size_t OFF_SR = OFF_RC, OFF_SK = OFF_RC + PIECE_B, OFF_SKK = OFF_RC + 2 * PIECE_B, OFF_SB = OFF_RC + 3 * PIECE_B;
constexpr size_t OFF_SE = OFF_PQ, OFF_SV = OFF_PK, OFF_SG = OFF_PV;
constexpr size_t OFF_Y = OFF_SR; constexpr size_t OFF_HB2 = OFF_RC;
constexpr int VT_LD = 2112;
static_assert(OFF_PX + (size_t)MALL * 256 * 2 <= OFF_RC && OFF_RC + 4 * PIECE_B <= WS_END && OFF_BONUS + (size_t)MALL * 8 * 4 <= OFF_RA && OFF_RA + (size_t)MALL * 1024 * 2 <= OFF_RB, "ws map");
static_assert(OFF_VT + (size_t)32 * 128 * VT_LD * 2 <= WS_END && OFF_ACT + (size_t)MALL * DFF * 2 <= OFF_RC && OFF_Y + (size_t)MMAIN * 512 * 2 <= OFF_SK, "ws map 2");

struct Params { const float* in[28]; float* out; unsigned char* ws; };
enum { I_X = 0, I_META, I_F1N, I_F1G, I_F1U, I_F1D, I_MIXN, I_WIN, I_QN, I_KN, I_LAMV, I_AON, I_MU, I_W0, I_WUP, I_A0, I_AUP, I_GUP, I_KK, I_KA, I_RK, I_LNW, I_LNB, I_WOUT, I_F2N, I_F2G, I_F2U, I_F2D };

__device__ __forceinline__ float wave_sum(float v) {
#pragma unroll
    for (int o = 1; o < 64; o <<= 1) v += __shfl_xor(v, o);
    return v;
}
__device__ __forceinline__ float bf2f(unsigned h) { return __uint_as_float(h << 16); }
__device__ __forceinline__ unsigned pk2(float lo, float hi) { return pg8::cvt_pk_bf16(lo, hi); }
__device__ __forceinline__ int rowof(int b, int pos) { return pos < NMETA ? MMAIN + pos : b * SEQ + pos - NMETA; }
#define ROW_ROR_ADD(x, n) ((x) + __builtin_bit_cast(float, __builtin_amdgcn_update_dpp(0, __builtin_bit_cast(int, (x)), 0x120 + (n), 0xf, 0xf, false)))
__device__ __forceinline__ float row16_allsum(float x) { x = ROW_ROR_ADD(x, 8); x = ROW_ROR_ADD(x, 4); x = ROW_ROR_ADD(x, 2); x = ROW_ROR_ADD(x, 1); return x; }

__device__ __forceinline__ void transpose_item(const float* __restrict__ W, int K, int N, bf16* WT, int dest_row0, const float* __restrict__ gain, LAS float* scr, int k0, int n0, int lane) {
    const int c4 = 4 * (lane & 7), r8 = lane >> 3;
    f32x4 v[8]; float g[8];
#pragma unroll
    for (int i = 0; i < 8; ++i) { const int kk = r8 + 8 * i; v[i] = __builtin_nontemporal_load((const f32x4*)(W + (size_t)(k0 + kk) * N + n0 + c4)); g[i] = gain ? gain[k0 + kk] : 1.0f; }
#pragma unroll
    for (int i = 0; i < 8; ++i) { const int kk = r8 + 8 * i; LAS float* d = scr + kk * 33 + c4; d[0] = v[i][0] * g[i]; d[1] = v[i][1] * g[i]; d[2] = v[i][2] * g[i]; d[3] = v[i][3] * g[i]; }
    LDS_WAIT(); asm volatile("" ::: "memory");
    const int c = lane & 7;
#pragma unroll
    for (int j = 0; j < 4; ++j) { const int n = (lane >> 3) + 8 * j; const LAS float* s = scr + (8 * c) * 33 + n;
        u32x4 o; o.x = pk2(s[0 * 33], s[1 * 33]); o.y = pk2(s[2 * 33], s[3 * 33]); o.z = pk2(s[4 * 33], s[5 * 33]); o.w = pk2(s[6 * 33], s[7 * 33]);
        *(u32x4*)(WT + (size_t)(dest_row0 + n) * K + k0 + 8 * c) = o; }
    LDS_WAIT(); asm volatile("" ::: "memory");
}
__device__ __forceinline__ void mat_item(const float* W, int K, int N, bf16* WT, int mode, const float* gain, LAS float* scr, int r, int lane) {
    const int nblk = N / 32, kb = r / nblk, nb = r % nblk, k0 = 64 * kb, n0 = 32 * nb;
    const int dest = mode == 0 ? n0 : (256 * (n0 / 128) + (n0 % 128) + (mode == 2 ? 128 : 0));
    transpose_item(W, K, N, WT, dest, gain, scr, k0, n0, lane);
}
__device__ __forceinline__ void rms_row_to_bf16(const float* src, bf16* dst, int lane) {
    f32x4 v[4]; float s = 0.f;
#pragma unroll
    for (int j = 0; j < 4; ++j) { v[j] = src ? ((const f32x4*)src)[lane + 64 * j] : (f32x4){0.f, 0.f, 0.f, 0.f}; s += (v[j].x * v[j].x + v[j].y * v[j].y) + (v[j].z * v[j].z + v[j].w * v[j].w); }
    const float rstd = __builtin_amdgcn_rsqf(wave_sum(s) * (1.0f / 1024.0f) + 1e-6f);
#pragma unroll
    for (int j = 0; j < 4; ++j) { u32x2 o; o.x = pk2(v[j].x * rstd, v[j].y * rstd); o.y = pk2(v[j].z * rstd, v[j].w * rstd); ((u32x2*)dst)[lane + 64 * j] = o; }
}
__device__ __forceinline__ void conv_set(const Params& P, LAS unsigned char* lds, int set, int w, int nw, int wid, int lane) {
    LAS float* scr = (LAS float*)(lds + wid * 8704);
    unsigned char* ws = P.ws;
    constexpr int I_G = 16 * 88, I_D = 44 * 32, I_IN = 16 * 104, I_O = 16 * 32, I_L = 16, I_LG2 = 32;
    const int nit = set == 0 ? 2 * I_G + 2 * I_L + I_LG2 : (set == 1 ? I_D + I_IN : (set == 2 ? I_O + 2 * I_G : I_D));
    for (int it = w; it < nit; it += nw) {
        int r = it;
        if (set == 0) {
            if (r < I_G) { mat_item(P.in[I_F1G], 1024, DFF, (bf16*)(ws + OFF_WGU1), 1, P.in[I_F1N], scr, r, lane); continue; } r -= I_G;
            if (r < I_G) { mat_item(P.in[I_F1U], 1024, DFF, (bf16*)(ws + OFF_WGU1), 2, P.in[I_F1N], scr, r, lane); continue; } r -= I_G;
            if (r < I_L) { mat_item(P.in[I_WUP], 64, 512, (bf16*)(ws + OFF_LW), 0, nullptr, scr, r, lane); continue; } r -= I_L;
            if (r < I_L) { mat_item(P.in[I_AUP], 64, 512, (bf16*)(ws + OFF_LA), 0, nullptr, scr, r, lane); continue; } r -= I_L;
            mat_item(P.in[I_GUP], 128, 512, (bf16*)(ws + OFF_LG), 0, nullptr, scr, r, lane);
        } else if (set == 1) {
            if (r < I_D) { mat_item(P.in[I_F1D], DFF, 1024, (bf16*)(ws + OFF_WD1), 0, nullptr, scr, r, lane); continue; } r -= I_D;
            mat_item(P.in[I_WIN], 1024, INC, (bf16*)(ws + OFF_WIN), 0, P.in[I_MIXN], scr, r, lane);
        } else if (set == 2) {
            if (r < I_O) { mat_item(P.in[I_WOUT], 1024, 1024, (bf16*)(ws + OFF_WOUT), 0, nullptr, scr, r, lane); continue; } r -= I_O;
            if (r < I_G) { mat_item(P.in[I_F2G], 1024, DFF, (bf16*)(ws + OFF_WGU2), 1, P.in[I_F2N], scr, r, lane); continue; } r -= I_G;
            mat_item(P.in[I_F2U], 1024, DFF, (bf16*)(ws + OFF_WGU2), 2, P.in[I_F2N], scr, r, lane);
        } else {
            mat_item(P.in[I_F2D], DFF, 1024, (bf16*)(ws + OFF_WD2), 0, nullptr, scr, r, lane);
        }
    }
}
__device__ __forceinline__ void conv_idle(const Params& P, LAS unsigned char* lds, int set, int nwg, int G, int wid, int lane) {
    const int c0 = nwg % G; if ((int)blockIdx.x < c0) return;
    conv_set(P, lds, set, ((int)blockIdx.x - c0) * NWAVES + wid, (G - c0) * NWAVES, wid, lane);
}
__device__ __forceinline__ void p0_prologue(const Params& P, LAS unsigned char* lds, int gw, int NGW, int wid, int lane) {
    unsigned char* ws = P.ws;
    conv_set(P, lds, 0, gw, NGW, wid, lane);
    { float* zz = (float*)(ws + OFF_SS1); for (int i = gw * 64 + lane; i < 2 * 16640; i += NGW * 64) zz[i] = 0.f; }
    bf16* A1 = (bf16*)(ws + OFF_RA);
    for (int m0 = 4 * gw; m0 < MALL; m0 += 4 * NGW) {
        f32x4 v[4][4]; float ss[4];
#pragma unroll
        for (int r = 0; r < 4; ++r) { const int m = m0 + r;
            const float* src = m < MMAIN ? P.in[I_X] + (size_t)m * DM : (m < MVALID ? P.in[I_META] + (size_t)(m - MMAIN) * DM : nullptr);
#pragma unroll
            for (int j = 0; j < 4; ++j) v[r][j] = src ? __builtin_nontemporal_load((const f32x4*)src + lane + 64 * j) : (f32x4){0.f, 0.f, 0.f, 0.f}; }
#pragma unroll
        for (int r = 0; r < 4; ++r) { float s = 0.f;
#pragma unroll
            for (int j = 0; j < 4; ++j) s += (v[r][j].x * v[r][j].x + v[r][j].y * v[r][j].y) + (v[r][j].z * v[r][j].z + v[r][j].w * v[r][j].w);
            s = row16_allsum(s); s += __shfl_xor(s, 16); s += __shfl_xor(s, 32); ss[r] = s; }
#pragma unroll
        for (int r = 0; r < 4; ++r) { const float ms = ss[r] * (1.0f / 1024.0f) + 1e-6f; const float rstd = __builtin_amdgcn_rsqf(ms); bf16* dst = A1 + (size_t)(m0 + r) * DM;
            if (lane == 0) ((float*)(ws + OFF_RMS0))[m0 + r] = ms * rstd;
#pragma unroll
            for (int j = 0; j < 4; ++j) { u32x2 o; o.x = pk2(v[r][j].x * rstd, v[r][j].y * rstd); o.y = pk2(v[r][j].z * rstd, v[r][j].w * rstd); ((u32x2*)dst)[lane + 64 * j] = o; } }
    }
}
#define XB_TMO      128
#define XB_XCNT(j)  (256  + 64 * (j))
#define XB_XSUB(j)  (1280 + 64 * (j))
#define XB_XGEN(j)  (2304 + 64 * (j))
#define XB_TOP      3328
#define XB_TOPGEN   3392
#define XCD_BAR_WORDS 3456
#define XB_SPIN_CAP (1u << 18)

__device__ __forceinline__ unsigned xb_ld(unsigned* p)              { return __hip_atomic_load(p, __ATOMIC_RELAXED, __HIP_MEMORY_SCOPE_AGENT); }
__device__ __forceinline__ unsigned xb_add(unsigned* p, unsigned v) { return __hip_atomic_fetch_add(p, v, __ATOMIC_RELAXED, __HIP_MEMORY_SCOPE_AGENT); }
__device__ __forceinline__ unsigned xb_xcc_id() { return (unsigned)__builtin_amdgcn_s_getreg((3 << 11) | 20) & 0xFu; }
#define XB_SPIN(cond, bar) do { unsigned _sp = 0; while (cond) { __builtin_amdgcn_s_sleep(1); \
    if ((++_sp & 255u) == 0u) { if (xb_ld(&(bar)[XB_TMO])) break; if (_sp > XB_SPIN_CAP) { atomicAdd(&(bar)[XB_TMO], 1u); break; } } } } while (0)

struct XcdBarrier {
    unsigned* bar; unsigned x;
    volatile LAS unsigned* st;
};

__device__ __forceinline__ XcdBarrier xcd_barrier_post(unsigned* bar, volatile LAS unsigned* st) {
    XcdBarrier b; b.bar = bar; b.x = xb_xcc_id(); b.st = st;
    if (threadIdx.x == 0) (void)xb_add(&bar[XB_XCNT(b.x)], 1u);
    return b;
}
__device__ __forceinline__ void xcd_barrier_complete(unsigned* bar, unsigned x, unsigned& nloc, unsigned& nx) {
    const unsigned G = gridDim.x * gridDim.y * gridDim.z;
    unsigned sum, cnt, mine, sp = 0u;
    for (;;) {
        sum = 0u; cnt = 0u; mine = 0u;
#pragma unroll
        for (unsigned j = 0; j < 16; ++j) { const unsigned c = xb_ld(&bar[XB_XCNT(j)]); sum += c; cnt += (c > 0u) ? 1u : 0u; mine = (j == x) ? c : mine; }
        if (sum == G) break;
        __builtin_amdgcn_s_sleep(1);
        if ((++sp & 255u) == 0u) { if (xb_ld(&bar[XB_TMO])) break; if (sp > XB_SPIN_CAP) { atomicAdd(&bar[XB_TMO], 1u); break; } }
    }
    nloc = mine > 0u ? mine : 1u; nx = cnt > 0u ? cnt : 1u;
}

__device__ __forceinline__ void xcd_barrier(const XcdBarrier& b) {
    asm volatile("s_waitcnt vmcnt(0)" ::: "memory");
    __syncthreads();
    if (threadIdx.x == 0) {
        unsigned* bar = b.bar;
        __builtin_amdgcn_s_waitcnt(0);
        unsigned nloc = b.st[0], nx = b.st[1];
        if (nloc == 0u) { xcd_barrier_complete(bar, b.x, nloc, nx); b.st[0] = nloc; b.st[1] = nx; }
        const unsigned old = xb_add(&bar[XB_XSUB(b.x)], 1u);
        const unsigned gen = old / nloc;
        if (old + 1u == (gen + 1u) * nloc) {
            __builtin_amdgcn_fence(__ATOMIC_RELEASE, "agent");
            asm volatile("s_waitcnt vmcnt(0)" ::: "memory");
            const unsigned og = xb_add(&bar[XB_TOP], 1u);
            const unsigned tg = og / nx;
            if (og + 1u == (tg + 1u) * nx) xb_add(&bar[XB_TOPGEN], 1u);
            else XB_SPIN(xb_ld(&bar[XB_TOPGEN]) == tg, bar);
            __builtin_amdgcn_fence(__ATOMIC_ACQUIRE, "agent");
            xb_add(&bar[XB_XGEN(b.x)], 1u);
            asm volatile("s_waitcnt vmcnt(0)" ::: "memory");
        } else {
            XB_SPIN(xb_ld(&bar[XB_XGEN(b.x)]) == gen, bar);
            __builtin_amdgcn_fence(__ATOMIC_ACQUIRE, "agent");
            asm volatile("s_waitcnt vmcnt(0)" ::: "memory");
        }
    }
    __syncthreads();
}

__device__ __forceinline__ f32x4 meta_tile(const bf16* __restrict__ A, int lda, const bf16* __restrict__ Brow, int K, int lane) {
    const int fr = lane & 15, fq = lane >> 4; const bf16* ap = A + (size_t)fr * lda + 8 * fq; const bf16* bp = Brow + (size_t)fr * K + 8 * fq;
    f32x4 acc = (f32x4){0.f, 0.f, 0.f, 0.f};
#pragma unroll 8
    for (int k = 0; k < K; k += 32) acc = __builtin_amdgcn_mfma_f32_16x16x32_bf16(*(const bf16x8*)(bp + k), *(const bf16x8*)(ap + k), acc, 0, 0, 0);
    return acc;
}
__device__ __forceinline__ int meta_task(int t_per_block_wave, int wid, int G) { return (G - 1 - (int)blockIdx.x) * NWAVES + wid; }
__device__ __forceinline__ void meta_gu1(const Params& P, int wid, int G, int lane) {
    const int fr = lane & 15, fq = lane >> 4; unsigned char* ws = P.ws;
    const bf16* A = (const bf16*)(ws + OFF_RA) + (size_t)MMAIN * DM; const bf16* W = (const bf16*)(ws + OFF_WGU1); bf16* ACT = (bf16*)(ws + OFF_ACT);
    for (int t = meta_task(0, wid, G); t < DFF / 16; t += G * NWAVES) {
        const int n0 = 16 * t; const bf16* gr = W + (size_t)(256 * (n0 / 128) + (n0 % 128)) * DM;
        const f32x4 g = meta_tile(A, DM, gr, DM, lane), u = meta_tile(A, DM, gr + (size_t)128 * DM, DM, lane);
        u32x2 w; w.x = pk2(pg8::silu_f(g[0]) * u[0], pg8::silu_f(g[1]) * u[1]); w.y = pk2(pg8::silu_f(g[2]) * u[2], pg8::silu_f(g[3]) * u[3]);
        *(u32x2*)(ACT + (size_t)(MMAIN + fr) * DFF + n0 + 4 * fq) = w;
    }
}
__device__ __forceinline__ void meta_d1(const Params& P, int wid, int G, int lane) {
    const int fr = lane & 15, fq = lane >> 4; unsigned char* ws = P.ws;
    const bf16* A = (const bf16*)(ws + OFF_ACT) + (size_t)MMAIN * DFF; const bf16* W = (const bf16*)(ws + OFF_WD1); bf16* HB = (bf16*)(ws + OFF_RA); float* ss1 = (float*)(ws + OFF_SS1);
    for (int t = wid * G + (int)blockIdx.x; t < DM / 16; t += G * NWAVES) {
        const int n0 = 16 * t; const f32x4 a = meta_tile(A, DFF, W + (size_t)n0 * DFF, DFF, lane);
        const f32x4 o = *(const f32x4*)(P.in[I_META] + (size_t)fr * DM + n0 + 4 * fq) + a * 0.5f;
        u32x2 w; w.x = pk2(o[0], o[1]); w.y = pk2(o[2], o[3]); *(u32x2*)(HB + (size_t)(MMAIN + fr) * DM + n0 + 4 * fq) = w;
        float ss = (o[0] * o[0] + o[1] * o[1]) + (o[2] * o[2] + o[3] * o[3]); ss += __shfl_xor(ss, 16); ss += __shfl_xor(ss, 32);
        if (fq == 0) atomicAdd(ss1 + MMAIN + fr, ss);
    }
}
__device__ __forceinline__ void meta_win(const Params& P, int wid, int G, int lane) {
    const int fr = lane & 15, fq = lane >> 4; unsigned char* ws = P.ws;
    const bf16* A = (const bf16*)(ws + OFF_RA) + (size_t)MMAIN * DM; const bf16* W = (const bf16*)(ws + OFF_WIN); bf16* PB = (bf16*)(ws + OFF_RB); const float* ss1 = (const float*)(ws + OFF_SS1);
    for (int t = meta_task(0, wid, G); t < INC / 16; t += G * NWAVES) {
        const int n0 = 16 * t; f32x4 a = meta_tile(A, DM, W + (size_t)n0 * DM, DM, lane);
        a = a * __builtin_amdgcn_rsqf(ss1[MMAIN + fr] * (1.0f / 1024.0f) + 1e-6f);
        const int pt = n0 >= 3072 ? 6 : (n0 >> 9), ld = pt == 6 ? 256 : 512, colt = n0 - (pt == 6 ? 3072 : (pt << 9));
        u32x2 w; w.x = pk2(a[0], a[1]); w.y = pk2(a[2], a[3]); *(u32x2*)(PB + (size_t)pt * PIECE_E + (size_t)(MMAIN + fr) * ld + colt + 4 * fq) = w;
    }
}

constexpr float QSCALE = 0.125f * 1.44269504f;
__device__ __forceinline__ u32x4 qk_norm_vals(u32x4 raw, const float* __restrict__ gain, float scale, int lane) {
    float x[8];
#pragma unroll
    for (int i = 0; i < 4; ++i) { x[2 * i] = bf2f(raw[i] & 0xffffu); x[2 * i + 1] = bf2f(raw[i] >> 16); }
    float ss = 0.f;
#pragma unroll
    for (int i = 0; i < 8; ++i) ss += x[i] * x[i];
    ss += __shfl_xor(ss, 1); ss += __shfl_xor(ss, 2); ss += __shfl_xor(ss, 4);
    const float rstd = scale * __builtin_amdgcn_rsqf(ss * (1.0f / 64.0f) + 1e-6f);
    const f32x4 g0 = *(const f32x4*)(gain + 8 * (lane & 7)), g1 = *(const f32x4*)(gain + 8 * (lane & 7) + 4);
    u32x4 o; o.x = pk2(x[0] * rstd * g0[0], x[1] * rstd * g0[1]); o.y = pk2(x[2] * rstd * g0[2], x[3] * rstd * g0[3]);
    o.z = pk2(x[4] * rstd * g1[0], x[5] * rstd * g1[1]); o.w = pk2(x[6] * rstd * g1[2], x[7] * rstd * g1[3]);
    return o;
}
__device__ __forceinline__ void prepA_phase(const Params& P, int gw, int wid, int G, int NGW, int lane) {
    bf16* PQ = (bf16*)(P.ws + OFF_PQ); bf16* PK = (bf16*)(P.ws + OFF_PK); const bf16* PV = (const bf16*)(P.ws + OFF_PV); bf16* Vt = (bf16*)(P.ws + OFF_VT);
    for (int row0 = 4 * gw; row0 < MVALID; row0 += 4 * NGW) {
        u32x4 rk[4];
#pragma unroll
        for (int r = 0; r < 4; ++r) rk[r] = *(const u32x4*)(PK + (size_t)(row0 + r) * 512 + 8 * lane);
#pragma unroll
        for (int r = 0; r < 4; ++r) *(u32x4*)(PK + (size_t)(row0 + r) * 512 + 8 * lane) = qk_norm_vals(rk[r], P.in[I_KN], 1.0f, lane);
    }
    for (int it = wid * G + (int)blockIdx.x; it < 32 * 33; it += NGW) {
        const int bh = it / 33, j = it % 33, b = bh >> 2, hh = bh & 3, pos = 64 * j + lane; const bool valid = pos < LPOS;
        const int row = rowof(b, valid ? pos : 0);
        const u32x4* src = (const u32x4*)(PV + (size_t)row * 512 + hh * 128);
        u32x4 v[16];
#pragma unroll
        for (int i = 0; i < 16; ++i) v[i] = valid ? src[i] : (u32x4){0u, 0u, 0u, 0u};
        bf16* dst = Vt + (size_t)bh * 128 * VT_LD + pos;
#pragma unroll
        for (int i = 0; i < 16; ++i)
#pragma unroll
            for (int jj = 0; jj < 8; ++jj) { const unsigned w = v[i][jj >> 1]; dst[(size_t)(8 * i + jj) * VT_LD] = (bf16)((jj & 1) ? (w >> 16) : (w & 0xffffu)); }
    }
}

__device__ __forceinline__ void att_qk(const LAS unsigned char* Kb, const bf16x8 (&qf)[2][2], int nst, int j, int qpos, float slope2, int fr, int fq, f32x4 (&sc)[2][4]) {
    constexpr int KSTR = 272;
#pragma unroll
    for (int st = 0; st < 4; ++st) {
        if (st < nst) {
            const float d0 = (float)(qpos - (64 * j + 16 * st + 4 * fq));
            f32x4 s0;
#pragma unroll
            for (int e = 0; e < 4; ++e) s0[e] = -slope2 * __builtin_fabsf(d0 - (float)e) - 12.0f;
            f32x4 s1 = s0;
#pragma unroll
            for (int ks = 0; ks < 2; ++ks) {
                const bf16x8 k0 = *(const LAS bf16x8*)(Kb + (16 * st + fr) * KSTR + (32 * ks + 8 * fq) * 2);
                const bf16x8 k1 = *(const LAS bf16x8*)(Kb + (16 * st + fr) * KSTR + (64 + 32 * ks + 8 * fq) * 2);
                s0 = __builtin_amdgcn_mfma_f32_16x16x32_bf16(k0, qf[0][ks], s0, 0, 0, 0);
                s1 = __builtin_amdgcn_mfma_f32_16x16x32_bf16(k1, qf[1][ks], s1, 0, 0, 0);
            }
            sc[0][st] = s0; sc[1][st] = s1;
        }
    }
}
__device__ __forceinline__ void att_pv(const LAS unsigned char* Vb, int nst, const f32x4 (&sc)[2][4], f32x4 (&O)[2][8], float& l0, float& l1, int fr, int fq) {
    constexpr int VSTR = 144;
    if (nst <= 0) return;
    unsigned pw[2][4][2];
#pragma unroll
    for (int st = 0; st < 4; ++st) {
        if (st < nst) {
            float p0[4], p1[4];
#pragma unroll
            for (int e = 0; e < 4; ++e) { p0[e] = __builtin_amdgcn_exp2f(sc[0][st][e]); p1[e] = __builtin_amdgcn_exp2f(sc[1][st][e]); l0 += p0[e]; l1 += p1[e]; }
            pw[0][st][0] = pk2(p0[0], p0[1]); pw[0][st][1] = pk2(p0[2], p0[3]); pw[1][st][0] = pk2(p1[0], p1[1]); pw[1][st][1] = pk2(p1[2], p1[3]);
        } else { pw[0][st][0] = 0u; pw[0][st][1] = 0u; pw[1][st][0] = 0u; pw[1][st][1] = 0u; }
    }
#pragma unroll
    for (int ks2 = 0; ks2 < 2; ++ks2) {
        if (ks2 == 0 || nst == 4) {
            const u32x4 a0 = (u32x4){pw[0][2 * ks2][0], pw[0][2 * ks2][1], pw[0][2 * ks2 + 1][0], pw[0][2 * ks2 + 1][1]};
            const u32x4 a1 = (u32x4){pw[1][2 * ks2][0], pw[1][2 * ks2][1], pw[1][2 * ks2 + 1][0], pw[1][2 * ks2 + 1][1]};
            const bf16x8 pf0 = __builtin_bit_cast(bf16x8, a0), pf1 = __builtin_bit_cast(bf16x8, a1);
#pragma unroll
            for (int dt = 0; dt < 8; ++dt) {
                const LAS unsigned char* vp = Vb + (16 * dt + fr) * VSTR + (32 * ks2 + 4 * fq) * 2;
                const u32x2 va = *(const LAS u32x2*)vp, vb2 = *(const LAS u32x2*)(vp + 32);
                const bf16x8 vf = __builtin_bit_cast(bf16x8, (u32x4){va.x, va.y, vb2.x, vb2.y});
                O[0][dt] = __builtin_amdgcn_mfma_f32_16x16x32_bf16(vf, pf0, O[0][dt], 0, 0, 0);
                O[1][dt] = __builtin_amdgcn_mfma_f32_16x16x32_bf16(vf, pf1, O[1][dt], 0, 0, 0);
            }
        }
    }
}
__device__ __forceinline__ void attn_phase(const Params& P, LAS unsigned char* lds, int tid, int wid, int lane) {
    const int fr = lane & 15, fq = lane >> 4;
    const bf16* PQ = (const bf16*)(P.ws + OFF_PQ); const bf16* PK = (const bf16*)(P.ws + OFF_PK); const bf16* Vt = (const bf16*)(P.ws + OFF_VT); bf16* CAT = (bf16*)(P.ws + OFF_RA);
    float lam; { const float* lv = P.in[I_LAMV]; float a = lv[lane] * lv[64 + lane], c = lv[128 + lane] * lv[192 + lane]; a = wave_sum(a); c = wave_sum(c); lam = __expf(a) - __expf(c) + 0.2f; }
    constexpr int KSTR = 272, VSTR = 144, KBUF = 64 * KSTR, VBUF = 128 * VSTR, VOFF = 2 * KBUF;
    const int kr = tid >> 3, kseg = tid & 7, vr = tid >> 2, vseg = tid & 3;
    const int vcu_ = (gridDim.x % 8 == 0) ? ((int)blockIdx.x % 8) * ((int)gridDim.x / 8) + (int)blockIdx.x / 8 : (int)blockIdx.x;
    for (int it = vcu_; it < 512; it += gridDim.x) {
        const int i2 = it & 255, hi = it >> 8, bh = i2 >> 3, cpl = i2 & 7, cp = hi ? 15 - cpl : cpl, b = bh >> 2, hh = bh & 3;
        const int c = 2 * cp + (wid >> 2), qframe = 128 * cp + 16 * wid + fr, qpos = qframe + NMETA, nt = 2 * cp + 3;
        const float slope2 = 1.44269504f * __builtin_amdgcn_exp2f(-2.0f * (float)(hh + 1));
        const bf16* qrow = PQ + (size_t)(b * SEQ + qframe) * 512 + hh * 128;
        bf16x8 qf[2][2];
#pragma unroll
        for (int cm = 0; cm < 2; ++cm)
#pragma unroll
            for (int ks = 0; ks < 2; ++ks) qf[cm][ks] = *(const bf16x8*)(qrow + 64 * cm + 32 * ks + 8 * fq);
#pragma unroll
        for (int cm = 0; cm < 2; ++cm) {
            float x[2][8]; float ss = 0.f;
#pragma unroll
            for (int ks = 0; ks < 2; ++ks) { const u32x4 raw = __builtin_bit_cast(u32x4, qf[cm][ks]);
#pragma unroll
                for (int i = 0; i < 4; ++i) { x[ks][2 * i] = bf2f(raw[i] & 0xffffu); x[ks][2 * i + 1] = bf2f(raw[i] >> 16); ss += x[ks][2 * i] * x[ks][2 * i] + x[ks][2 * i + 1] * x[ks][2 * i + 1]; } }
            ss += __shfl_xor(ss, 16); ss += __shfl_xor(ss, 32);
            const float rq_ = QSCALE * __builtin_amdgcn_rsqf(ss * (1.0f / 64.0f) + 1e-6f);
#pragma unroll
            for (int ks = 0; ks < 2; ++ks) { const f32x4 g0 = *(const f32x4*)(P.in[I_QN] + 32 * ks + 8 * fq), g1 = *(const f32x4*)(P.in[I_QN] + 32 * ks + 8 * fq + 4);
                const u32x4 w = (u32x4){pk2(x[ks][0] * rq_ * g0[0], x[ks][1] * rq_ * g0[1]), pk2(x[ks][2] * rq_ * g0[2], x[ks][3] * rq_ * g0[3]), pk2(x[ks][4] * rq_ * g1[0], x[ks][5] * rq_ * g1[1]), pk2(x[ks][6] * rq_ * g1[2], x[ks][7] * rq_ * g1[3])};
                qf[cm][ks] = __builtin_bit_cast(bf16x8, w); }
        }
        f32x4 O[2][8];
#pragma unroll
        for (int cm = 0; cm < 2; ++cm)
#pragma unroll
            for (int dt = 0; dt < 8; ++dt) O[cm][dt] = (f32x4){0.f, 0.f, 0.f, 0.f};
        float l0 = 0.f, l1 = 0.f;
        u32x4 ak0, ak1, av0, av1;
#define ATT_LOADK(S, j) do { int pos_ = 64 * (j) + kr; pos_ = pos_ < LPOS ? pos_ : LPOS - 1; const bf16* kp_ = PK + (size_t)rowof(b, pos_) * 512 + hh * 128 + 8 * kseg; S##k0 = *(const u32x4*)kp_; S##k1 = *(const u32x4*)(kp_ + 64); } while (0)
#define ATT_LOADV(S, j) do { const bf16* vp_ = Vt + ((size_t)bh * 128 + vr) * VT_LD + 64 * (j) + 8 * vseg; S##v0 = *(const u32x4*)vp_; S##v1 = *(const u32x4*)(vp_ + 32); } while (0)
#define ATT_WRITEK(S, buf) do { LAS unsigned char* kb_ = lds + (buf) * KBUF + kr * KSTR + kseg * 16; *(LAS u32x4*)kb_ = S##k0; *(LAS u32x4*)(kb_ + 128) = S##k1; } while (0)
#define ATT_WRITEV(S, buf) do { LAS unsigned char* vb_ = lds + VOFF + (buf) * VBUF + vr * VSTR + vseg * 16; *(LAS u32x4*)vb_ = S##v0; *(LAS u32x4*)(vb_ + 64) = S##v1; } while (0)
#define ATT_BAR() do { asm volatile("s_waitcnt lgkmcnt(0)" ::: "memory"); __builtin_amdgcn_s_barrier(); asm volatile("" ::: "memory"); } while (0)
#define ATT_NST(j) (((j) <= c) ? 4 : ((j) == c + 1 ? 1 : 0))
        __syncthreads();
        ATT_LOADK(a, 0); ATT_LOADV(a, 0); ATT_WRITEK(a, 0); ATT_WRITEV(a, 0);
        if (nt > 1) { ATT_LOADK(a, 1); ATT_WRITEK(a, 1); }
        __syncthreads();
        f32x4 scA[2][4], scB[2][4];
        att_qk(lds, qf, ATT_NST(0), 0, qpos, slope2, fr, fq, scA);
        for (int j = 0; j < nt; j += 2) {
            if (j + 1 < nt) { if (j + 2 < nt) ATT_LOADK(a, j + 2); ATT_LOADV(a, j + 1); }
            if (j + 1 < nt) att_qk(lds + KBUF, qf, ATT_NST(j + 1), j + 1, qpos, slope2, fr, fq, scB);
            att_pv(lds + VOFF, ATT_NST(j), scA, O, l0, l1, fr, fq);
            if (j + 1 < nt) { if (j + 2 < nt) ATT_WRITEK(a, 0); ATT_WRITEV(a, 1); }
            ATT_BAR();
            if (j + 1 >= nt) break;
            if (j + 2 < nt) { if (j + 3 < nt) ATT_LOADK(a, j + 3); ATT_LOADV(a, j + 2); }
            if (j + 2 < nt) att_qk(lds, qf, ATT_NST(j + 2), j + 2, qpos, slope2, fr, fq, scA);
            att_pv(lds + VOFF + VBUF, ATT_NST(j + 1), scB, O, l0, l1, fr, fq);
            if (j + 2 < nt) { if (j + 3 < nt) ATT_WRITEK(a, 1); ATT_WRITEV(a, 0); }
            ATT_BAR();
        }
#undef ATT_LOADK
#undef ATT_LOADV
#undef ATT_WRITEK
#undef ATT_WRITEV
#undef ATT_BAR
#undef ATT_NST
        l0 += __shfl_xor(l0, 16); l0 += __shfl_xor(l0, 32); l1 += __shfl_xor(l1, 16); l1 += __shfl_xor(l1, 32);
        const float inv0 = __builtin_amdgcn_rcpf(l0), inv1 = lam * __builtin_amdgcn_rcpf(l1); float ss = 0.f;
#pragma unroll
        for (int dt = 0; dt < 8; ++dt) { O[0][dt] = O[0][dt] * inv0 - O[1][dt] * inv1; ss += (O[0][dt][0] * O[0][dt][0] + O[0][dt][1] * O[0][dt][1]) + (O[0][dt][2] * O[0][dt][2] + O[0][dt][3] * O[0][dt][3]); }
        ss += __shfl_xor(ss, 16); ss += __shfl_xor(ss, 32);
        const float rstd = 0.8f * __builtin_amdgcn_rsqf(ss * (1.0f / 128.0f) + 1e-6f);
        bf16* orow = CAT + (size_t)(b * SEQ + qframe) * 1024 + hh * 128 + 4 * fq; const float* og = P.in[I_AON] + 4 * fq;
#pragma unroll
        for (int dt = 0; dt < 8; ++dt) { const f32x4 g = *(const f32x4*)(og + 16 * dt); u32x2 o; o.x = pk2(O[0][dt][0] * rstd * g[0], O[0][dt][1] * rstd * g[1]); o.y = pk2(O[0][dt][2] * rstd * g[2], O[0][dt][3] * rstd * g[3]);
            *(u32x2*)(orow + 16 * dt) = o; }
    }
}
__device__ __forceinline__ void ld8(const bf16* p, bool ok, float (&x)[8]) {
    u32x4 raw = ok ? *(const u32x4*)p : (u32x4){0u, 0u, 0u, 0u};
#pragma unroll
    for (int i = 0; i < 4; ++i) { x[2 * i] = bf2f(raw[i] & 0xffffu); x[2 * i + 1] = bf2f(raw[i] >> 16); }
}
__device__ __forceinline__ void ld4(const bf16* p, bool ok, float (&x)[4]) {
    u32x2 raw = ok ? *(const u32x2*)p : (u32x2){0u, 0u};
    x[0] = bf2f(raw.x & 0xffffu); x[1] = bf2f(raw.x >> 16); x[2] = bf2f(raw.y & 0xffffu); x[3] = bf2f(raw.y >> 16);
}
__device__ __forceinline__ void lerp4(const bf16* base, int row, int prow, int col, const float* __restrict__ mu, float (&x)[4]) {
    float p[4], pp[4]; ld4(base + (size_t)row * 512 + col, true, p); ld4(base + (size_t)(prow < 0 ? 0 : prow) * 512 + col, prow >= 0, pp);
    const f32x4 m = *(const f32x4*)(mu + col);
#pragma unroll
    for (int e = 0; e < 4; ++e) x[e] = p[e] + (pp[e] - p[e]) * m[e];
}
__device__ __forceinline__ u32x4 pkh8(const float (&x)[8]) { typedef _Float16 h16x8 __attribute__((ext_vector_type(8))); h16x8 h = (h16x8){(h16)x[0], (h16)x[1], (h16)x[2], (h16)x[3], (h16)x[4], (h16)x[5], (h16)x[6], (h16)x[7]}; return __builtin_bit_cast(u32x4, h); }
__device__ __forceinline__ u32x2 pkh4(float a, float b, float c, float d) { h16x4 h = (h16x4){(h16)a, (h16)b, (h16)c, (h16)d}; return __builtin_bit_cast(u32x2, h); }
__device__ __forceinline__ void prepR_phase(const Params& P, int wid, int G, int NGW, int lane) {
    const int fr = lane & 15, fq = lane >> 4; unsigned char* ws = P.ws;
    const bf16* PR = (const bf16*)(ws + OFF_PR); const bf16* PKR = (const bf16*)(ws + OFF_PKR); const bf16* PVR = (const bf16*)(ws + OFF_PVR); const bf16* PX = (const bf16*)(ws + OFF_PX);
    const bf16* LW = (const bf16*)(ws + OFF_LW); const bf16* LA = (const bf16*)(ws + OFF_LA); const bf16* LG = (const bf16*)(ws + OFF_LG);
    h16* SR = (h16*)(ws + OFF_SR); h16* SK = (h16*)(ws + OFF_SK); h16* SKK = (h16*)(ws + OFF_SKK); h16* SB = (h16*)(ws + OFF_SB); h16* SE = (h16*)(ws + OFF_SE); h16* SV = (h16*)(ws + OFF_SV); h16* SG = (h16*)(ws + OFF_SG);
    float* BON = (float*)(ws + OFF_BONUS);
    const float* mu = P.in[I_MU];
    for (int it = wid * G + (int)blockIdx.x; it < (MMAIN / 16) * 2 + 8; it += NGW) {
        const bool mt = it >= (MMAIN / 16) * 2; const int h0 = mt ? it - (MMAIN / 16) * 2 : 4 * (it & 1), nh = mt ? 1 : 4; const int row_raw = (mt ? MMAIN : 16 * (it >> 1)) + fr; const bool valid = row_raw < MVALID; const int row = valid ? row_raw : 0;
        const int prow = (row >= MMAIN) ? (row == MMAIN ? -1 : row - 1) : ((row & (SEQ - 1)) == 0 ? MVALID - 1 : row - 1);
        bf16x8 xwf[2], xaf[2], xgf[4];
#pragma unroll
        for (int ks = 0; ks < 8; ++ks) {
            const int col = 32 * ks + 8 * fq; float p[8], pp[8]; ld8(PX + (size_t)row * 256 + col, true, p); ld8(PX + (size_t)(prow < 0 ? 0 : prow) * 256 + col, prow >= 0, pp);
            const f32x4 m0 = *(const f32x4*)(mu + 1536 + col), m1 = *(const f32x4*)(mu + 1536 + col + 4); float x[8];
#pragma unroll
            for (int e = 0; e < 8; ++e) { const float m = e < 4 ? m0[e & 3] : m1[e & 3]; x[e] = p[e] + (pp[e] - p[e]) * m; }
            if (ks < 2) {
#pragma unroll
                for (int e = 0; e < 8; ++e) { const float t = __expf(-2.0f * __builtin_fabsf(x[e])); const float th = (1.0f - t) * __builtin_amdgcn_rcpf(1.0f + t); x[e] = x[e] < 0.f ? -th : th; }
            } else if (ks >= 4) {
#pragma unroll
                for (int e = 0; e < 8; ++e) x[e] = __builtin_amdgcn_rcpf(1.0f + __expf(-x[e]));
            }
            const u32x4 w = (u32x4){pk2(x[0], x[1]), pk2(x[2], x[3]), pk2(x[4], x[5]), pk2(x[6], x[7])};
            const bf16x8 f = __builtin_bit_cast(bf16x8, w);
            if (ks < 2) xwf[ks] = f; else if (ks < 4) xaf[ks - 2] = f; else xgf[ks - 4] = f;
        }
#pragma unroll 1
        for (int h = h0; h < h0 + nh; ++h) {
            f32x4 wacc[4], aacc[4], gacc[4];
#pragma unroll
            for (int nt = 0; nt < 4; ++nt) {
                wacc[nt] = (f32x4){0.f, 0.f, 0.f, 0.f}; aacc[nt] = wacc[nt]; gacc[nt] = wacc[nt];
                const int chr = h * 64 + 16 * (fr >> 2) + 4 * nt + (fr & 3);
#pragma unroll
                for (int ks = 0; ks < 2; ++ks) {
                    const bf16x8 bw = *(const bf16x8*)(LW + (size_t)chr * 64 + 32 * ks + 8 * fq), ba = *(const bf16x8*)(LA + (size_t)chr * 64 + 32 * ks + 8 * fq);
                    wacc[nt] = __builtin_amdgcn_mfma_f32_16x16x32_bf16(bw, xwf[ks], wacc[nt], 0, 0, 0);
                    aacc[nt] = __builtin_amdgcn_mfma_f32_16x16x32_bf16(ba, xaf[ks], aacc[nt], 0, 0, 0);
                }
#pragma unroll
                for (int ks = 0; ks < 4; ++ks) {
                    const bf16x8 bg = *(const bf16x8*)(LG + (size_t)chr * 128 + 32 * ks + 8 * fq);
                    gacc[nt] = __builtin_amdgcn_mfma_f32_16x16x32_bf16(bg, xgf[ks], gacc[nt], 0, 0, 0);
                }
            }
            float kk[4][4], as[4][4], sskk = 0.f, bon = 0.f;
            const int col16 = h * 64 + 16 * fq;
#pragma unroll
            for (int hf = 0; hf < 2; ++hf) {
                const int col = col16 + 8 * hf; float r8[8], k8[8], v8[8], pp[8];
                { ld8(PR + (size_t)row * 512 + col, true, r8); ld8(PR + (size_t)(prow < 0 ? 0 : prow) * 512 + col, prow >= 0, pp); const f32x4 m0 = *(const f32x4*)(mu + col), m1 = *(const f32x4*)(mu + col + 4);
#pragma unroll
                  for (int e = 0; e < 8; ++e) r8[e] += (pp[e] - r8[e]) * (e < 4 ? m0[e & 3] : m1[e & 3]); }
                { ld8(PKR + (size_t)row * 512 + col, true, k8); ld8(PKR + (size_t)(prow < 0 ? 0 : prow) * 512 + col, prow >= 0, pp); const f32x4 m0 = *(const f32x4*)(mu + 512 + col), m1 = *(const f32x4*)(mu + 512 + col + 4);
#pragma unroll
                  for (int e = 0; e < 8; ++e) k8[e] += (pp[e] - k8[e]) * (e < 4 ? m0[e & 3] : m1[e & 3]); }
                { ld8(PVR + (size_t)row * 512 + col, true, v8); ld8(PVR + (size_t)(prow < 0 ? 0 : prow) * 512 + col, prow >= 0, pp); const f32x4 m0 = *(const f32x4*)(mu + 1024 + col), m1 = *(const f32x4*)(mu + 1024 + col + 4);
#pragma unroll
                  for (int e = 0; e < 8; ++e) v8[e] += (pp[e] - v8[e]) * (e < 4 ? m0[e & 3] : m1[e & 3]); }
                float ev[8], kh[8], gg[8];
#pragma unroll
                for (int q = 0; q < 2; ++q) {
                    const int nt = 2 * hf + q;
                    const f32x4 w0 = *(const f32x4*)(P.in[I_W0] + col + 4 * q), a0 = *(const f32x4*)(P.in[I_A0] + col + 4 * q), kkw = *(const f32x4*)(P.in[I_KK] + col + 4 * q), kaw = *(const f32x4*)(P.in[I_KA] + col + 4 * q), rkw = *(const f32x4*)(P.in[I_RK] + col + 4 * q);
#pragma unroll
                    for (int e = 0; e < 4; ++e) {
                        const int i8 = 4 * q + e;
                        const float xs = -(w0[e] + wacc[nt][e]);
                        const float sp = fmaxf(xs, 0.f) + __logf(1.0f + __expf(-__builtin_fabsf(xs)));
                        ev[i8] = __expf(-sp - 0.5f);
                        const float a = __builtin_amdgcn_rcpf(1.0f + __expf(-(a0[e] + aacc[nt][e])));
                        as[nt][e] = a; kk[nt][e] = k8[i8] * kkw[e]; sskk += kk[nt][e] * kk[nt][e];
                        kh[i8] = k8[i8] * (1.0f + (a - 1.0f) * kaw[e]);
                        bon += r8[i8] * kh[i8] * rkw[e];
                        gg[i8] = gacc[nt][e];
                    }
                }
                if (valid) { const size_t o = (size_t)row * 512 + col;
                    *(u32x4*)(SE + o) = pkh8(ev); *(u32x4*)(SV + o) = pkh8(v8); *(u32x4*)(SG + o) = pkh8(gg); }
            }
            sskk += __shfl_xor(sskk, 16); sskk += __shfl_xor(sskk, 32); bon += __shfl_xor(bon, 16); bon += __shfl_xor(bon, 32);
            const float inv = __builtin_amdgcn_rsqf(fmaxf(sskk, 1e-24f));
            if (valid) {
#pragma unroll
                for (int hf = 0; hf < 2; ++hf) { const size_t o = (size_t)row * 512 + col16 + 8 * hf; float kn[8], bb[8];
#pragma unroll
                    for (int i8 = 0; i8 < 8; ++i8) { const int nt = 2 * hf + (i8 >> 2), e = i8 & 3; kn[i8] = kk[nt][e] * inv; bb[i8] = kn[i8] * as[nt][e]; }
                    float aa[8];
#pragma unroll
                    for (int i8 = 0; i8 < 8; ++i8) aa[i8] = as[2 * hf + (i8 >> 2)][i8 & 3];
                    *(u32x4*)(SKK + o) = pkh8(kn); *(u32x4*)(SK + o) = pkh8(aa); }
                if (fq == 0) BON[(size_t)row * 8 + h] = bon;
            }
        }
    }
}

constexpr int TC = 32, RECB = 1616, SBUF = TC * RECB, YOFF = 2 * SBUF;
struct ScanRegs { u32x2 raw[6]; u32x2 rr[3]; u32x2 rk[3]; u32x2 rv; };
__device__ __forceinline__ void scan_gload(const Params& P, ScanRegs& R, int b, int h, int rg, int ck, int ll) {
    const unsigned char* ws = P.ws;
    const h16* arr[3] = {(const h16*)(ws + OFF_SE), (const h16*)(ws + OFF_SK)  , (const h16*)(ws + OFF_SKK)};
    const int sub = ll & 15, p = ll >> 4;
#pragma unroll
    for (int i = 0; i < 6; ++i) { const int t = 2 * p + (i & 1), a = i >> 1; int pos = TC * ck + t; pos = pos < LPOS ? pos : LPOS - 1;
        R.raw[i] = *(const u32x2*)(arr[a] + (size_t)rowof(b, pos) * 512 + h * 64 + 4 * sub); }
    { const bf16* PRb = (const bf16*)(ws + OFF_PR);
#pragma unroll
      for (int k = 0; k < 3; ++k) { const int pos = TC * ck + 2 * p - 1 + k; const int pc = pos < 0 ? 0 : (pos < LPOS ? pos : LPOS - 1);
          const size_t o_ = (size_t)rowof(b, pc) * 512 + h * 64 + 4 * sub; const u32x2 v = *(const u32x2*)(PRb + o_), vk = *(const u32x2*)((const bf16*)(ws + OFF_PKR) + o_);
          R.rr[k] = pos < 0 ? (u32x2){0u, 0u} : v; R.rk[k] = pos < 0 ? (u32x2){0u, 0u} : vk; } }
    { const int l2 = ll & 127, t = l2 >> 2, q = l2 & 3; int pos = TC * ck + t; pos = pos < LPOS ? pos : LPOS - 1; R.rv = *(const u32x2*)((const h16*)(ws + OFF_SV) + (size_t)rowof(b, pos) * 512 + h * 64 + 16 * rg + 4 * q); }
}
__device__ __forceinline__ f32x4 h4f(u32x2 r) { const h16x4 hv = __builtin_bit_cast(h16x4, r); return (f32x4){(float)hv[0], (float)hv[1], (float)hv[2], (float)hv[3]}; }
__device__ __forceinline__ f32x4 b4f(u32x2 r) { return (f32x4){__uint_as_float(r.x << 16), __uint_as_float(r.x & 0xffff0000u), __uint_as_float(r.y << 16), __uint_as_float(r.y & 0xffff0000u)}; }
__device__ __forceinline__ void scan_cvt_write(const Params& P, int h, const ScanRegs& R, LAS unsigned char* buf, int ll) {
    const int sub = ll & 15, p = ll >> 4;
    f32x4 f[5][2];
#pragma unroll
    for (int st = 0; st < 2; ++st) { f[0][st] = h4f(R.raw[st]); f[2][st] = h4f(R.raw[4 + st]); }
    { const f32x4 muk = *(const f32x4*)(P.in[I_MU] + 512 + h * 64 + 4 * sub), ka4 = *(const f32x4*)(P.in[I_KA] + h * 64 + 4 * sub), km = b4f(R.rk[0]), k0 = b4f(R.rk[1]), k1 = b4f(R.rk[2]);
      const f32x4 a0_ = h4f(R.raw[2]), a1_ = h4f(R.raw[3]), kl0 = k0 + (km - k0) * muk, kl1 = k1 + (k0 - k1) * muk;
      f[1][0] = kl0 * ((a0_ - 1.0f) * ka4 + 1.0f); f[1][1] = kl1 * ((a1_ - 1.0f) * ka4 + 1.0f); f[3][0] = f[2][0] * a0_; f[3][1] = f[2][1] * a1_; }
    { const f32x4 mu = *(const f32x4*)(P.in[I_MU] + h * 64 + 4 * sub), pm = b4f(R.rr[0]), p0 = b4f(R.rr[1]), p1 = b4f(R.rr[2]); f[4][0] = p0 + (pm - p0) * mu; f[4][1] = p1 + (p0 - p1) * mu; }
#pragma unroll
    for (int st = 0; st < 2; ++st) { f[0][st][0] = __expf(-f[0][st][0]); f[0][st][1] = __expf(-f[0][st][1]); f[0][st][2] = __expf(-f[0][st][2]); f[0][st][3] = __expf(-f[0][st][3]); }
    LAS unsigned char* r0 = buf + (2 * p) * RECB + sub * 16; LAS unsigned char* r1 = r0 + RECB;
#pragma unroll
    for (int a = 0; a < 5; ++a) { *(LAS f32x4*)(r0 + a * 256) = f[a][0]; *(LAS f32x4*)(r1 + a * 256) = f[a][1]; }
    *(LAS f32x4*)(r0 + 1344) = f[0][0] * f[2][1];
    float be = (f[3][0][0] * f[2][1][0] + f[3][0][1] * f[2][1][1]) + (f[3][0][2] * f[2][1][2] + f[3][0][3] * f[2][1][3]);
    float ka = (f[1][0][0] * f[2][1][0] + f[1][0][1] * f[2][1][1]) + (f[1][0][2] * f[2][1][2] + f[1][0][3] * f[2][1][3]);
    be = row16_allsum(be); ka = row16_allsum(ka);
    if (sub == 0) { typedef float f32x2v __attribute__((ext_vector_type(2))); *(LAS f32x2v*)(buf + (2 * p) * RECB + 1600) = (f32x2v){be, ka}; }
    if (ll < 128) { const int t = ll >> 2, q = ll & 3; *(LAS f32x4*)(buf + t * RECB + 1280 + q * 16) = h4f(R.rv); }
}
__device__ __forceinline__ void scan_flush(const Params& P, const LAS unsigned char* yb, int b, int h, int rg, int ck, int ll) {
    if (ll < 128) { const int t = ll >> 2, q = ll & 3, pos = TC * ck + t;
        if (pos >= NMETA && pos < LPOS) { h16* Y = (h16*)(P.ws + OFF_Y); const f32x4 yv = *(const LAS f32x4*)(yb + t * 64 + q * 16); *(u32x2*)(Y + (size_t)(b * SEQ + pos - NMETA) * 512 + h * 64 + 16 * rg + 4 * q) = pkh4(yv[0], yv[1], yv[2], yv[3]); } }
}
#define SC_BAR() do { asm volatile("s_waitcnt lgkmcnt(0)" ::: "memory"); __builtin_amdgcn_s_barrier(); asm volatile("" ::: "memory"); } while (0)
__device__ __forceinline__ float dot4(f32x4 a, f32x4 b) { return __builtin_fmaf(a[3], b[3], __builtin_fmaf(a[2], b[2], __builtin_fmaf(a[1], b[1], a[0] * b[0]))); }
__device__ __forceinline__ void scan_phase(const Params& P, LAS unsigned char* lds, int tid, int wid, int lane) {
    constexpr int NCK = (LPOS + TC - 1) / TC;
    typedef float f32x2v __attribute__((ext_vector_type(2)));
    const int vcu_ = (gridDim.x % 8 == 0) ? ((int)blockIdx.x % 8) * ((int)gridDim.x / 8) + (int)blockIdx.x / 8 : (int)blockIdx.x;
    for (int it = vcu_; it < 256; it += gridDim.x) {
        const int bh = it >> 2, rg = it & 3, b = bh >> 3, h = bh & 7;
        f32x4 S = (f32x4){0.f, 0.f, 0.f, 0.f};
        const int jq = lane & 15, il = 4 * wid + (lane >> 4), ll = tid - 256;
        ScanRegs R;
        SC_BAR();
        if (wid >= 4) { scan_gload(P, R, b, h, rg, 0, ll); scan_cvt_write(P, h, R, lds, ll); scan_gload(P, R, b, h, rg, 1, ll); }
        SC_BAR();
        for (int ck = 0; ck < NCK; ++ck) {
            const int nsteps = (LPOS - TC * ck) < TC ? (LPOS - TC * ck) : TC;
            if (wid >= 4) {
                if (ck + 1 < NCK) { scan_cvt_write(P, h, R, lds + ((ck + 1) & 1) * SBUF, ll); scan_gload(P, R, b, h, rg, ck + 2 < NCK ? ck + 2 : NCK - 1, ll); }
                if (ck > 0) scan_flush(P, lds + YOFF + ((ck - 1) & 1) * 2048, b, h, rg, ck - 1, ll);
            } else {
                const LAS unsigned char* buf = lds + (ck & 1) * SBUF + jq * 16; const LAS unsigned char* vbuf = lds + (ck & 1) * SBUF + 1280 + il * 4; const LAS unsigned char* sbuf = lds + (ck & 1) * SBUF + 1600;
                LAS float* yb = (LAS float*)(lds + YOFF + (ck & 1) * 2048);
                f32x4 w0[2], kh0[2], kk0[2], b0[2], r0[2], wk0[2], w1[2], kh1[2], b1[2], r1[2]; float v0[2], v1[2]; f32x2v bk[2];
#define SC_LOADP(s, t) do { const LAS unsigned char* e_ = buf + (t) * RECB; const LAS unsigned char* o_ = e_ + RECB; \
                    w0[s] = *(const LAS f32x4*)(e_); kh0[s] = *(const LAS f32x4*)(e_ + 256); kk0[s] = *(const LAS f32x4*)(e_ + 512); b0[s] = *(const LAS f32x4*)(e_ + 768); r0[s] = *(const LAS f32x4*)(e_ + 1024); wk0[s] = *(const LAS f32x4*)(e_ + 1344); \
                    w1[s] = *(const LAS f32x4*)(o_); kh1[s] = *(const LAS f32x4*)(o_ + 256); b1[s] = *(const LAS f32x4*)(o_ + 768); r1[s] = *(const LAS f32x4*)(o_ + 1024); \
                    v0[s] = *(const LAS float*)(vbuf + (t) * RECB); v1[s] = *(const LAS float*)(vbuf + (t) * RECB + RECB); bk[s] = *(const LAS f32x2v*)(sbuf + (t) * RECB); } while (0)
                SC_LOADP(0, 0);
                for (int t0 = 0; t0 < nsteps; t0 += 16) {
                    float ykeep = 0.f;
#pragma unroll
                    for (int u = 0; u < 8; ++u) {
                        SC_LOADP((u + 1) & 1, t0 + 2 * u + 2);
                        const int s = u & 1;
                        float dA = dot4(S, kk0[s]), dB = dot4(S, wk0[s]);
                        dA = row16_allsum(dA); dB = row16_allsum(dB);
                        const float sa0 = -dA;
                        const f32x4 S0 = S * w0[s] + (b0[s] * sa0 + kh0[s] * v0[s]);
                        const float sa1 = -(dB + sa0 * bk[s].x + v0[s] * bk[s].y);
                        const f32x4 S1 = S0 * w1[s] + (b1[s] * sa1 + kh1[s] * v1[s]);
                        float y0 = dot4(S0, r0[s]), y1 = dot4(S1, r1[s]);
                        y0 = row16_allsum(y0); y1 = row16_allsum(y1);
                        ykeep = (jq == 2 * u) ? y0 : ykeep; ykeep = (jq == 2 * u + 1) ? y1 : ykeep;
                        S = S1;
                    }
                    yb[(t0 + jq) * 16 + il] = ykeep;
                }
#undef SC_LOADP
            }
            SC_BAR();
        }
        if (wid >= 4) scan_flush(P, lds + YOFF + ((NCK - 1) & 1) * 2048, b, h, rg, NCK - 1, ll);
    }
}

__device__ __forceinline__ void post_phase(const Params& P, int gw, int NGW, int lane) {
    const h16* __restrict__ Y = (const h16*)(P.ws + OFF_Y); const h16* __restrict__ SV = (const h16*)(P.ws + OFF_SV); const h16* __restrict__ SG = (const h16*)(P.ws + OFF_SG); const float* __restrict__ BON = (const float*)(P.ws + OFF_BONUS); bf16* __restrict__ CAT = (bf16*)(P.ws + OFF_RA);
    const int q = lane & 15;
#pragma unroll 4
    for (int g = gw * 4 + (lane >> 4); g < MMAIN * 8; g += NGW * 4) {
        const int row = g >> 3, h = g & 7, col = h * 64 + 4 * q; const size_t o = (size_t)row * 512 + col;
        const f32x4 y = h4f(*(const u32x2*)(Y + o));
        const float mean = row16_allsum((y[0] + y[1]) + (y[2] + y[3])) * (1.0f / 64.0f);
        const f32x4 d = y - mean;
        const float var = row16_allsum((d[0] * d[0] + d[1] * d[1]) + (d[2] * d[2] + d[3] * d[3])) * (1.0f / 64.0f);
        const float rstd = __builtin_amdgcn_rsqf(var + 64e-5f);
        const h16x4 vv = __builtin_bit_cast(h16x4, *(const u32x2*)(SV + o)), gg = __builtin_bit_cast(h16x4, *(const u32x2*)(SG + o));
        const f32x4 lw = *(const f32x4*)(P.in[I_LNW] + col), lb = *(const f32x4*)(P.in[I_LNB] + col); const float bon = BON[(size_t)row * 8 + h];
        float r[4];
#pragma unroll
        for (int e = 0; e < 4; ++e) r[e] = (d[e] * rstd * lw[e] + lb[e] + bon * (float)vv[e]) * (float)gg[e];
        u32x2 w; w.x = pk2(r[0], r[1]); w.y = pk2(r[2], r[3]);
        *(u32x2*)(CAT + (size_t)row * 1024 + 512 + col) = w;
    }
}

#ifndef N_PHASES_PER_LAUNCH
#define N_PHASES_PER_LAUNCH 0
#endif
constexpr int NPHASE = 14;
__global__ void __launch_bounds__(NTHREADS, 2) mega(Params P, int ph_lo, int ph_hi) {
    extern __shared__ __attribute__((aligned(16))) unsigned char lds_raw[];
    LAS unsigned char* lds = (LAS unsigned char*)lds_raw;
    cg::grid_group grid = cg::this_grid();
    const int tid = threadIdx.x, lane = tid & 63, wid = __builtin_amdgcn_readfirstlane(tid >> 6);
    const int G = gridDim.x, gw = blockIdx.x * NWAVES + wid, NGW = G * NWAVES;
    unsigned char* ws = P.ws;
    volatile LAS unsigned* MISC = (volatile LAS unsigned*)(lds + 131072);
    if (tid < 4) MISC[tid] = 0u;
    __syncthreads();
    const XcdBarrier xbar = xcd_barrier_post((unsigned*)(ws + OFF_BAR), MISC);
    if (ph_lo < 0) grid.sync();
#define SEAM(k) do { if ((k) + 1 < ph_hi) xcd_barrier(xbar); } while (0)
#define IN(k) (ph_lo <= (k) && (k) < ph_hi)
#ifndef PROBE_DUP
#define PROBE_DUP 0
#endif
#define REP(k) for (int rep_ = 0; rep_ < 1 + ((PROBE_DUP >> (k)) & 1); ++rep_)
    float* ss1 = (float*)(ws + OFF_SS1); float* ss2 = (float*)(ws + OFF_SS2);
    if (IN(0)) REP(0) { p0_prologue(P, lds, gw, NGW, wid, lane); SEAM(0); }
    if (IN(1)) REP(1) { pg8::Gemm g{(const bf16*)(ws + OFF_RA), (const bf16*)(ws + OFF_WGU1), MMAIN, 2 * DFF, DM}; pg8::StaticOrder S; S.init(MMAIN, 2 * DFF, G, (int)blockIdx.x);
        pg8::EpiSwiGLU E{(bf16*)(ws + OFF_ACT), DFF, nullptr}; pg8::gemm_phase<pg8::EpiSwiGLU, pg8::StaticOrder, true, true>(lds, g, S, E); meta_gu1(P, wid, G, lane); conv_idle(P, lds, 1, (MMAIN / 256) * (2 * DFF / 256), G, wid, lane); SEAM(1); }
    if (IN(2)) { pg8::Gemm g{(const bf16*)(ws + OFF_ACT), (const bf16*)(ws + OFF_WD1), MMAIN, DM, DFF}; pg8::StaticOrder S; S.init(MMAIN, DM, G, (int)blockIdx.x);
        pg8::EpiResid E{nullptr, (const bf16*)(ws + OFF_RA), (const float*)(ws + OFF_RMS0), nullptr, (bf16*)P.out, ss1, 0.5f};     pg8::gemm_phase<pg8::EpiResid, pg8::StaticOrder, true, true>(lds, g, S, E); meta_d1(P, wid, G, lane); SEAM(2); }
    if (IN(4)) REP(4) { pg8::Gemm g{(const bf16*)P.out, (const bf16*)(ws + OFF_WIN), MMAIN, INC, DM}; pg8::StaticOrder S; S.init(MMAIN, INC, G, (int)blockIdx.x);
        pg8::EpiProj E{(bf16*)(ws + OFF_RB), PIECE_E, ss1}; pg8::gemm_phase<pg8::EpiProj, pg8::StaticOrder, true, true>(lds, g, S, E); meta_win(P, wid, G, lane); conv_idle(P, lds, 2, (MMAIN / 256) * (INC / 256), G, wid, lane); SEAM(4); }
    if (IN(5)) { prepA_phase(P, gw, wid, G, NGW, lane); SEAM(5); }
    if (IN(6)) REP(6) { attn_phase(P, lds, tid, wid, lane); SEAM(6); }
    if (IN(7)) REP(7) { prepR_phase(P, wid, G, NGW, lane); SEAM(7); }
    if (IN(8)) REP(8) { scan_phase(P, lds, tid, wid, lane); SEAM(8); }
    if (IN(9)) REP(9) { post_phase(P, gw, NGW, lane); SEAM(9); }
    if (IN(10)) { pg8::Gemm g{(const bf16*)(ws + OFF_RA), (const bf16*)(ws + OFF_WOUT), MMAIN, DM, DM}; pg8::StaticOrder S; S.init(MMAIN, DM, G, (int)blockIdx.x);
        pg8::EpiResid E{nullptr, (const bf16*)P.out, nullptr, nullptr, (bf16*)(ws + OFF_HB2), ss2, 1.0f}; pg8::gemm_phase<pg8::EpiResid, pg8::StaticOrder, true, true>(lds, g, S, E); SEAM(10); }
    if (IN(12)) REP(12) { pg8::Gemm g{(const bf16*)(ws + OFF_HB2), (const bf16*)(ws + OFF_WGU2), MMAIN, 2 * DFF, DM}; pg8::StaticOrder S; S.init(MMAIN, 2 * DFF, G, (int)blockIdx.x);
        pg8::EpiSwiGLU E{(bf16*)(ws + OFF_ACT), DFF, ss2}; pg8::gemm_phase<pg8::EpiSwiGLU, pg8::StaticOrder, true, true>(lds, g, S, E); conv_idle(P, lds, 3, (MMAIN / 256) * (2 * DFF / 256), G, wid, lane); SEAM(12); }
    if (IN(13)) { pg8::Gemm g{(const bf16*)(ws + OFF_ACT), (const bf16*)(ws + OFF_WD2), MMAIN, DM, DFF}; pg8::StaticOrder S; S.init(MMAIN, DM, G, (int)blockIdx.x);
        pg8::EpiResid E{nullptr, (const bf16*)(ws + OFF_HB2), nullptr, P.out, nullptr, nullptr, 0.5f}; pg8::gemm_phase<pg8::EpiResid, pg8::StaticOrder, true, true>(lds, g, S, E); }
#undef SEAM
#undef IN
}

extern "C" void kernel_launch(void* const* d_in, const int* in_sizes, int n_in, void* d_out, int out_size, void* d_ws, size_t ws_size, hipStream_t stream) {
    static int grid = 0;
    if (grid == 0) {
        if (n_in != 28 || out_size != MMAIN * DM || ws_size < WS_END) { fprintf(stderr, "kernel_launch: unexpected shapes (n_in %d out %d ws %zu)\n", n_in, out_size, ws_size); grid = -1; return; }
        int dev = 0, cus = 0, per_cu = 0;
        (void)hipGetDevice(&dev); (void)hipDeviceGetAttribute(&cus, hipDeviceAttributeMultiprocessorCount, dev);
        (void)hipFuncSetAttribute((const void*)mega, hipFuncAttributeMaxDynamicSharedMemorySize, LDS_BYTES);
        (void)hipOccupancyMaxActiveBlocksPerMultiprocessor(&per_cu, (const void*)mega, NTHREADS, LDS_BYTES);
        if (per_cu < 1) { fprintf(stderr, "kernel_launch: occupancy query says %d blocks per CU\n", per_cu); grid = -1; return; }
        grid = cus * (per_cu > 1 ? 1 : per_cu);
    }
    if (grid < 0) return;
    Params p{};
    for (int i = 0; i < 28; ++i) p.in[i] = (const float*)d_in[i];
    p.out = (float*)d_out; p.ws = (unsigned char*)d_ws;
    if (hipMemsetAsync((char*)d_ws + OFF_BAR, 0, 3456 * 4, stream) != hipSuccess) { fprintf(stderr, "kernel_launch: memset of the barrier words failed\n"); return; }
#if N_PHASES_PER_LAUNCH == 0
    int lo = 0, hi = NPHASE; void* args[] = {&p, &lo, &hi};
    hipError_t e = hipLaunchCooperativeKernel((const void*)mega, dim3(grid), dim3(NTHREADS), args, LDS_BYTES, stream);
    if (e != hipSuccess) fprintf(stderr, "cooperative launch failed: %s (grid %d)\n", hipGetErrorString(e), grid);
#else
    for (int k = 0; k < NPHASE; ++k) hipLaunchKernelGGL(mega, dim3(grid), dim3(NTHREADS), LDS_BYTES, stream, p, k, k + 1);
#endif
}
```

```cpp
#include <hip/hip_runtime.h>
#include <hip/hip_cooperative_groups.h>
#include <cstdio>
#include <cstdint>
namespace cg = cooperative_groups;
namespace pg8 {
#define PG8_LAS __attribute__((address_space(3)))
typedef unsigned short bf16_t;
typedef short bf16x8 __attribute__((ext_vector_type(8)));
typedef float f32x4 __attribute__((ext_vector_type(4)));
typedef unsigned u32x4 __attribute__((ext_vector_type(4)));
constexpr int BM = 256, BK = 64, HALF = 128, HTB = HALF * BK * 2  , STAGE_BYTES = 8 * HTB, NXCD = 8, WGM = 8;

__host__ __device__ __forceinline__ int lds_byte(int r, int c) { const int st = (r >> 4) * 2 + (c >> 5), rr = r & 15, cc = c & 31, ob = rr * 64 + cc * 2; return st * 1024 + (ob ^ (((ob >> 9) & 1) << 5)); }
__host__ __device__ __forceinline__ void stage_rc(int b, int& R, int& C) { const int st = b / 1024, sb = b % 1024, swz = sb ^ (((sb >> 9) & 1) << 5); R = (st >> 1) * 16 + swz / 64; C = (st & 1) * 32 + (swz % 64) / 2; }
__host__ __device__ __forceinline__ int perm32(int rho) { const int n = rho >> 4, i = rho & 15; return 8 * (i >> 2) + 4 * n + (i & 3); }

struct Unit { int pm, pn; };
struct Gemm { const bf16_t* A; const bf16_t* Bt; int M, N, K; };

struct StaticOrder {
    int nM, nN, nwg, G, c;
    __host__ __device__ void init(int M, int N, int G_, int c_) { nM = M / BM; nN = N / BM; nwg = nM * nN; G = G_; c = c_; }
    __host__ __device__ bool next(int i, Unit& u) const {
        const long L = (long)i * G + c; if (L >= nwg) return false;
        int wgid = (int)L; { const int q = nwg / NXCD, r = nwg % NXCD, xcd = wgid % NXCD, off = wgid / NXCD; wgid = (xcd < r ? xcd * (q + 1) : r * (q + 1) + (xcd - r) * q) + off; }
        const int nig = WGM * nN, gid = wgid / nig, fm = gid * WGM, gsz = (nM - fm) < WGM ? (nM - fm) : WGM;
        u.pm = fm + ((wgid % nig) % gsz); u.pn = (wgid % nig) / gsz; return true;
    }
    __device__ __forceinline__ void a_ready(const Unit&) const {}
    __device__ __forceinline__ void done(const Unit&) const {}
};

typedef __bf16 bf16x2_t __attribute__((ext_vector_type(2)));
typedef float f32x2_t __attribute__((ext_vector_type(2)));
__device__ __forceinline__ unsigned cvt_pk_bf16(float lo, float hi) { f32x2_t v = {lo, hi}; bf16x2_t b = __builtin_convertvector(v, bf16x2_t); return __builtin_bit_cast(unsigned, b); }
typedef float f32x2 __attribute__((ext_vector_type(2)));
typedef unsigned u32x2 __attribute__((ext_vector_type(2)));
__device__ __forceinline__ float silu_f(float g) { return g * __builtin_amdgcn_rcpf(1.0f + __builtin_amdgcn_exp2f(-1.44269504f * g)); }
struct EpiSwiGLU {
    static constexpr bool PERM = true, AFTER_DRAIN = false;
    bf16_t* O; int ldc; const float* rowss;
    __device__ __forceinline__ void operator()(const f32x4 (&acc)[2][2][4][2], const Unit& u, int wr, int wc, int fr, int fq) const {
        const int row0 = u.pm * BM + wr * 64 + fr, col0 = u.pn * HALF + wc * 32 + 8 * fq;
#pragma unroll
        for (int ai = 0; ai < 2; ++ai)
#pragma unroll
            for (int m = 0; m < 4; ++m) {
                const int row = row0 + ai * HALF + m * 16;
                const float rs = rowss ? __builtin_amdgcn_rsqf(rowss[row] * (1.0f / 1024.0f) + 1e-6f) : 1.0f;
                bf16_t* rowp = O + (size_t)row * ldc + col0;
                const f32x4 g0 = acc[ai][0][m][0] * rs, g1 = acc[ai][0][m][1] * rs, u0 = acc[ai][1][m][0] * rs, u1 = acc[ai][1][m][1] * rs;
                u32x4 w;
                w.x = cvt_pk_bf16(silu_f(g0[0]) * u0[0], silu_f(g0[1]) * u0[1]); w.y = cvt_pk_bf16(silu_f(g0[2]) * u0[2], silu_f(g0[3]) * u0[3]);
                w.z = cvt_pk_bf16(silu_f(g1[0]) * u1[0], silu_f(g1[1]) * u1[1]); w.w = cvt_pk_bf16(silu_f(g1[2]) * u1[2], silu_f(g1[3]) * u1[3]);
                *(u32x4*)rowp = w;
            }
    }
};
struct EpiResid {
    static constexpr bool PERM = true, AFTER_DRAIN = false;
    const float* basef; const bf16_t* baseh; const float* brow; float* out; bf16_t* hb; float* rowss; float scale;
    __device__ __forceinline__ void operator()(const f32x4 (&acc)[2][2][4][2], const Unit& u, int wr, int wc, int fr, int fq) const {
        const int col0 = u.pn * BM + wc * 32 + 8 * fq;
#pragma unroll
        for (int ai = 0; ai < 2; ++ai)
#pragma unroll
            for (int m = 0; m < 4; ++m) {
                const int row = u.pm * BM + ai * HALF + wr * 64 + m * 16 + fr; float ss = 0.f; const float bsc = brow ? brow[row] : 1.0f;
#pragma unroll
                for (int bj = 0; bj < 2; ++bj) { const size_t off = (size_t)row * 1024 + col0 + bj * HALF;
                    f32x4 b0, b1;
                    if (basef) { b0 = *(const f32x4*)(basef + off); b1 = *(const f32x4*)(basef + off + 4); }
                    else { const u32x4 r = *(const u32x4*)(baseh + off);
                        b0 = (f32x4){__uint_as_float(r.x << 16), __uint_as_float(r.x & 0xffff0000u), __uint_as_float(r.y << 16), __uint_as_float(r.y & 0xffff0000u)} * bsc;
                        b1 = (f32x4){__uint_as_float(r.z << 16), __uint_as_float(r.z & 0xffff0000u), __uint_as_float(r.w << 16), __uint_as_float(r.w & 0xffff0000u)} * bsc; }
                    const f32x4 o0 = b0 + acc[ai][bj][m][0] * scale, o1 = b1 + acc[ai][bj][m][1] * scale;
                    if (out) { __builtin_nontemporal_store(o0, (f32x4*)(out + off)); __builtin_nontemporal_store(o1, (f32x4*)(out + off + 4)); }
                    if (hb) { u32x4 w; w.x = cvt_pk_bf16(o0[0], o0[1]); w.y = cvt_pk_bf16(o0[2], o0[3]); w.z = cvt_pk_bf16(o1[0], o1[1]); w.w = cvt_pk_bf16(o1[2], o1[3]); *(u32x4*)(hb + off) = w;
                        ss += ((o0[0] * o0[0] + o0[1] * o0[1]) + (o0[2] * o0[2] + o0[3] * o0[3])) + ((o1[0] * o1[0] + o1[1] * o1[1]) + (o1[2] * o1[2] + o1[3] * o1[3])); } }
                if (hb) { ss += __shfl_xor(ss, 16); ss += __shfl_xor(ss, 32); if (fq == 0) atomicAdd(rowss + row, ss); }
            }
    }
};
struct EpiProj {
    static constexpr bool PERM = true, AFTER_DRAIN = false;
    bf16_t* P; size_t piece_elems; const float* rowss;
    __device__ __forceinline__ void operator()(const f32x4 (&acc)[2][2][4][2], const Unit& u, int wr, int wc, int fr, int fq) const {
        const int c0 = u.pn * BM; const int t = c0 >= 3072 ? 6 : (c0 >> 9); const int ld = (t == 6) ? 256 : 512; const int colt = c0 - (t == 6 ? 3072 : (t << 9));
        bf16_t* base = P + (size_t)t * piece_elems; const int row0 = u.pm * BM + wr * 64 + fr, col0 = colt + wc * 32 + 8 * fq;
#pragma unroll
        for (int ai = 0; ai < 2; ++ai)
#pragma unroll
            for (int m = 0; m < 4; ++m) { const int row = row0 + ai * HALF + m * 16; bf16_t* rowp = base + (size_t)row * ld + col0;
                const float rs = __builtin_amdgcn_rsqf(rowss[row] * (1.0f / 1024.0f) + 1e-6f);
#pragma unroll
                for (int bj = 0; bj < 2; ++bj) { const f32x4 v0 = acc[ai][bj][m][0] * rs, v1 = acc[ai][bj][m][1] * rs; u32x4 w;
                    w.x = cvt_pk_bf16(v0[0], v0[1]); w.y = cvt_pk_bf16(v0[2], v0[3]); w.z = cvt_pk_bf16(v1[0], v1[1]); w.w = cvt_pk_bf16(v1[2], v1[3]);
                    *(u32x4*)(rowp + bj * HALF) = w; } }
    }
};
template <class Epi, class Sched, bool ALIGN_EPI = false, bool SP2 = false>
__device__ __forceinline__ void gemm_phase(PG8_LAS unsigned char* lds, const Gemm g, const Sched& S, const Epi& E) {
    const int tid = threadIdx.x, wid = __builtin_amdgcn_readfirstlane(tid >> 6), lane = tid & 63, wr = wid >> 2, wc = wid & 3, fr = lane & 15, fq = lane >> 4;
    const int K = g.K, nt = K / BK;
    unsigned voffA[2], voffB[2];
#pragma unroll
    for (int i = 0; i < 2; ++i) { int R, C; stage_rc(tid * 16 + i * 8192, R, C); const int Rb = Epi::PERM ? ((R & ~31) + perm32(R & 31)) : R;
        voffA[i] = (unsigned)(R * K + C) * 2u; voffB[i] = (unsigned)(Rb * K + C) * 2u; }
    const size_t kstep = (size_t)(BK * 2);
    const size_t hstep = (size_t)HALF * K * 2;
    const size_t tstep = 2 * hstep;
    const unsigned ldsw = (unsigned)wid * 1024u;
    const int aoff = lds_byte(wr * 64 + fr, fq * 8), boff = lds_byte(wc * 32 + fr, fq * 8);
#define PG8_SA(b, h) (((b) * 2 + (h)) * HTB)
#define PG8_SB(b, h) ((4 + (b) * 2 + (h)) * HTB)
#define PG8_STAGE(bufoff, gbase, voff) do { _Pragma("unroll") for (int _i = 0; _i < 2; ++_i) \
        __builtin_amdgcn_global_load_lds((const unsigned*)((const char*)(gbase) + (voff)[_i]), (PG8_LAS unsigned*)(lds + (bufoff) + ldsw + _i * 8192), 16, 0, 0); } while (0)
#define PG8_LDA(dst, b, h) do { _Pragma("unroll") for (int m = 0; m < 4; ++m) _Pragma("unroll") for (int k = 0; k < 2; ++k) dst[m][k] = *(const PG8_LAS bf16x8*)(lds + PG8_SA(b, h) + aoff + m * 2048 + k * 1024); } while (0)
#define PG8_LDB(dst, b, h) do { _Pragma("unroll") for (int n = 0; n < 2; ++n) _Pragma("unroll") for (int k = 0; k < 2; ++k) dst[n][k] = *(const PG8_LAS bf16x8*)(lds + PG8_SB(b, h) + boff + n * 2048 + k * 1024); } while (0)
#define PG8_MMA(ai, bj, At, Bt) do { __builtin_amdgcn_s_setprio(1); _Pragma("unroll") for (int m = 0; m < 4; ++m) _Pragma("unroll") for (int n = 0; n < 2; ++n) _Pragma("unroll") for (int k = 0; k < 2; ++k) \
        acc[ai][bj][m][n] = __builtin_amdgcn_mfma_f32_16x16x32_bf16(Bt[n][k], At[m][k], acc[ai][bj][m][n], 0, 0, 0); __builtin_amdgcn_s_setprio(0); } while (0)
#define PG8_WAIT_V(n) asm volatile("s_waitcnt vmcnt(" #n ")" ::: "memory")
#define PG8_WAIT_L(n) asm volatile("s_waitcnt lgkmcnt(" #n ")" ::: "memory")
#define PG8_BAR __builtin_amdgcn_s_barrier()
#define PG8_SCHED __builtin_amdgcn_sched_barrier(0)
    Unit cur, nxt; int ui = 0;
    if (!S.next(0, cur)) return;
    f32x4 acc[2][2][4][2];
#pragma unroll
    for (int a = 0; a < 2; ++a)
#pragma unroll
        for (int b = 0; b < 2; ++b)
#pragma unroll
            for (int m = 0; m < 4; ++m)
#pragma unroll
                for (int n = 0; n < 2; ++n) acc[a][b][m][n] = (f32x4){0.f, 0.f, 0.f, 0.f};
    bf16x8 At[4][2], B0[2][2], B1[2][2];
    const char* cA = (const char*)g.A + (size_t)cur.pm * tstep; const char* cB = (const char*)g.Bt + (size_t)cur.pn * tstep;
    S.a_ready(cur);
    if constexpr (SP2) {
        PG8_STAGE(PG8_SB(0, 0), cB, voffB); PG8_STAGE(PG8_SB(0, 1), cB + hstep, voffB); PG8_STAGE(PG8_SA(0, 0), cA, voffA); PG8_STAGE(PG8_SA(0, 1), cA + hstep, voffA);
        if (wr == 1) PG8_BAR;
        PG8_WAIT_V(2); PG8_BAR;
        PG8_STAGE(PG8_SB(1, 0), cB + kstep, voffB); PG8_STAGE(PG8_SA(1, 0), cA + kstep, voffA); PG8_STAGE(PG8_SB(1, 1), cB + hstep + kstep, voffB);
        PG8_WAIT_V(6); PG8_BAR;
    } else {
        PG8_STAGE(PG8_SB(0, 0), cB, voffB); PG8_STAGE(PG8_SA(0, 0), cA, voffA); PG8_STAGE(PG8_SB(0, 1), cB + hstep, voffB); PG8_STAGE(PG8_SA(0, 1), cA + hstep, voffA);
        if (wr == 1) PG8_BAR;
        PG8_WAIT_V(4); PG8_BAR;
        PG8_STAGE(PG8_SB(1, 0), cB + kstep, voffB); PG8_STAGE(PG8_SA(1, 0), cA + kstep, voffA); PG8_STAGE(PG8_SB(1, 1), cB + hstep + kstep, voffB);
        PG8_WAIT_V(6); PG8_BAR;
    }
    for (;;) {
        const bool has_next = S.next(ui + 1, nxt);
        const char* nA = has_next ? (const char*)g.A + (size_t)nxt.pm * tstep : cA; const char* nB = has_next ? (const char*)g.Bt + (size_t)nxt.pn * tstep : cB;
        for (int t = 0; t < nt; t += 2) {
            const bool last = (t == nt - 2);
            const char* a1 = cA + (size_t)(t + 1) * kstep;
            const char* a2 = last ? nA : cA + (size_t)(t + 2) * kstep; const char* b2 = last ? nB : cB + (size_t)(t + 2) * kstep;
            const char* a3 = a2 + kstep; const char* b3 = b2 + kstep;
            if (last && has_next) S.a_ready(nxt);
            if constexpr (SP2) {
            PG8_LDB(B0, 0, 0); PG8_LDB(B1, 0, 1); PG8_SCHED; PG8_LDA(At, 0, 0); PG8_STAGE(PG8_SA(1, 1), a1 + hstep, voffA);
            PG8_WAIT_V(8); PG8_WAIT_L(0); PG8_BAR; PG8_MMA(0, 0, At, B0); PG8_MMA(0, 1, At, B1); PG8_BAR; PG8_SCHED;
            PG8_LDA(At, 0, 1); PG8_STAGE(PG8_SB(0, 0), b2, voffB); PG8_STAGE(PG8_SB(0, 1), b2 + hstep, voffB); PG8_STAGE(PG8_SA(0, 0), a2, voffA);
            PG8_WAIT_V(8); PG8_WAIT_L(0); PG8_BAR; PG8_MMA(1, 0, At, B0); PG8_MMA(1, 1, At, B1); PG8_BAR; PG8_SCHED;
            PG8_LDB(B0, 1, 0); PG8_LDB(B1, 1, 1); PG8_SCHED; PG8_LDA(At, 1, 0); PG8_STAGE(PG8_SA(0, 1), a2 + hstep, voffA);
            PG8_WAIT_V(8); PG8_WAIT_L(0); PG8_BAR; PG8_MMA(0, 0, At, B0); PG8_MMA(0, 1, At, B1); PG8_BAR; PG8_SCHED;
            PG8_LDA(At, 1, 1); PG8_STAGE(PG8_SB(1, 0), b3, voffB); PG8_STAGE(PG8_SB(1, 1), b3 + hstep, voffB); PG8_STAGE(PG8_SA(1, 0), a3, voffA);
            PG8_WAIT_V(8); PG8_WAIT_L(0); PG8_BAR; PG8_MMA(1, 0, At, B0); PG8_MMA(1, 1, At, B1); PG8_BAR; PG8_SCHED;
            } else {
            PG8_LDB(B0, 0, 0); PG8_SCHED; PG8_LDA(At, 0, 0); PG8_STAGE(PG8_SA(1, 1), a1 + hstep, voffA);
            PG8_WAIT_L(8); PG8_BAR; PG8_WAIT_L(0); PG8_MMA(0, 0, At, B0); PG8_BAR; PG8_SCHED;
            PG8_LDB(B1, 0, 1); PG8_STAGE(PG8_SB(0, 0), b2, voffB);
            PG8_BAR; PG8_WAIT_L(0); PG8_MMA(0, 1, At, B1); PG8_BAR;
            PG8_LDA(At, 0, 1); PG8_STAGE(PG8_SA(0, 0), a2, voffA);
            PG8_BAR; PG8_WAIT_L(0); PG8_MMA(1, 0, At, B0); PG8_BAR; PG8_SCHED;
            PG8_STAGE(PG8_SB(0, 1), b2 + hstep, voffB);
            PG8_WAIT_V(6); PG8_BAR; PG8_MMA(1, 1, At, B1); PG8_BAR;
            PG8_LDB(B0, 1, 0); PG8_SCHED; PG8_LDA(At, 1, 0); PG8_STAGE(PG8_SA(0, 1), a2 + hstep, voffA);
            PG8_WAIT_L(8); PG8_BAR; PG8_WAIT_L(0); PG8_MMA(0, 0, At, B0); PG8_BAR; PG8_SCHED;
            PG8_LDB(B1, 1, 1); PG8_STAGE(PG8_SB(1, 0), b3, voffB);
            PG8_BAR; PG8_WAIT_L(0); PG8_MMA(0, 1, At, B1); PG8_BAR;
            PG8_LDA(At, 1, 1); PG8_STAGE(PG8_SA(1, 0), a3, voffA);
            PG8_BAR; PG8_WAIT_L(0); PG8_MMA(1, 0, At, B0); PG8_BAR; PG8_SCHED;
            PG8_STAGE(PG8_SB(1, 1), b3 + hstep, voffB);
            PG8_WAIT_V(6); PG8_BAR; PG8_MMA(1, 1, At, B1); PG8_BAR;
            }
        }
        if constexpr (ALIGN_EPI) { if (wr == 0) PG8_BAR; }
        if constexpr (!Epi::AFTER_DRAIN) { E(acc, cur, wr, wc, fr, fq); S.done(cur); }
        if (!has_next) break;
#pragma unroll
        for (int a = 0; a < 2; ++a)
#pragma unroll
            for (int b = 0; b < 2; ++b)
#pragma unroll
                for (int m = 0; m < 4; ++m)
#pragma unroll
                    for (int n = 0; n < 2; ++n) acc[a][b][m][n] = (f32x4){0.f, 0.f, 0.f, 0.f};
        cur = nxt; cA = nA; cB = nB; ++ui;
        if constexpr (ALIGN_EPI) { if (wr == 1) PG8_BAR; }
    }
    PG8_WAIT_V(0);
    if constexpr (!ALIGN_EPI) { if (wr == 0) PG8_BAR; }
    PG8_BAR;
    if constexpr (Epi::AFTER_DRAIN) { E.fused(acc, cur, wr, wc, fr, fq, lds, wid, lane); S.done(cur); }
#undef PG8_SA
#undef PG8_SB
#undef PG8_STAGE
#undef PG8_LDA
#undef PG8_LDB
#undef PG8_MMA
#undef PG8_WAIT_V
#undef PG8_WAIT_L
#undef PG8_BAR
#undef PG8_SCHED
}
}
#define LAS __attribute__((address_space(3)))
typedef unsigned short bf16;
typedef short bf16x8 __attribute__((ext_vector_type(8)));
typedef float f32x4 __attribute__((ext_vector_type(4)));
typedef unsigned u32x4 __attribute__((ext_vector_type(4)));
typedef unsigned u32x2 __attribute__((ext_vector_type(2)));
typedef _Float16 h16;
typedef _Float16 h16x4 __attribute__((ext_vector_type(4)));
#define LDS_WAIT() asm volatile("s_waitcnt lgkmcnt(0)" ::: "memory")

constexpr int DM = 1024, NBATCH = 8, SEQ = 2048, NMETA = 16, LPOS = 2064, DFF = 2816, INC = 3328;
constexpr int MMAIN = 16384, MALL = 16640, MVALID = 16400;
constexpr int NWAVES = 8, NTHREADS = 512;
constexpr int LDS_BYTES = 135168;
constexpr size_t OFF_WGU1 = 0, OFF_WD1 = 11534336, OFF_WIN = 17301504, OFF_WOUT = 24117248, OFF_WGU2 = 26214400, OFF_WD2 = 37748736;
constexpr size_t OFF_LW = 43515904, OFF_LA = 43581440, OFF_LG = 43646976, OFF_HM = 43778048, OFF_BONUS = 44826624;
constexpr size_t OFF_SS1 = 45359104, OFF_SS2 = OFF_SS1 + 16640 * 4;
constexpr size_t OFF_BAR = OFF_SS2 + 16640 * 4;
constexpr size_t OFF_RMS0 = OFF_BAR + 3456 * 4;
static_assert(OFF_BAR % 256 == 0 && OFF_RMS0 % 256 == 0 && OFF_RMS0 + 16640 * 4 <= 46137344, "ws map 0");
constexpr size_t OFF_RA = 46137344, OFF_RB = 80740352, OFF_RC = 191889408, WS_END = 260046848;
constexpr size_t PIECE_B = 17039360, PIECE_E = PIECE_B / 2;
constexpr size_t OFF_PQ = OFF_RB, OFF_PK = OFF_RB + PIECE_B, OFF_PV = OFF_RB + 2 * PIECE_B, OFF_PR = OFF_RB + 3 * PIECE_B, OFF_PKR = OFF_RB + 4 * PIECE_B, OFF_PVR = OFF_RB + 5 * PIECE_B, OFF_PX = OFF_RB + 6 * PIECE_B;
constexpr size_t OFF_ACT = OFF_RB, OFF_VT = OFF_RC;
constexpr size_t OFF_SR = OFF_RC, OFF_SK = OFF_RC + PIECE_B, OFF_SKK = OFF_RC + 2 * PIECE_B, OFF_SB = OFF_RC + 3 * PIECE_B;
constexpr size_t OFF_SE = OFF_PQ, OFF_SV = OFF_PK, OFF_SG = OFF_PV;
constexpr size_t OFF_Y = OFF_SR; constexpr size_t OFF_HB2 = OFF_RC;
constexpr int VT_LD = 2112;
static_assert(OFF_PX + (size_t)MALL * 256 * 2 <= OFF_RC && OFF_RC + 4 * PIECE_B <= WS_END && OFF_BONUS + (size_t)MALL * 8 * 4 <= OFF_RA && OFF_RA + (size_t)MALL * 1024 * 2 <= OFF_RB, "ws map");
static_assert(OFF_VT + (size_t)32 * 128 * VT_LD * 2 <= WS_END && OFF_ACT + (size_t)MALL * DFF * 2 <= OFF_RC && OFF_Y + (size_t)MMAIN * 512 * 2 <= OFF_SK, "ws map 2");

struct Params { const float* in[28]; float* out; unsigned char* ws; };
enum { I_X = 0, I_META, I_F1N, I_F1G, I_F1U, I_F1D, I_MIXN, I_WIN, I_QN, I_KN, I_LAMV, I_AON, I_MU, I_W0, I_WUP, I_A0, I_AUP, I_GUP, I_KK, I_KA, I_RK, I_LNW, I_LNB, I_WOUT, I_F2N, I_F2G, I_F2U, I_F2D };

__device__ __forceinline__ float wave_sum(float v) {
#pragma unroll
    for (int o = 1; o < 64; o <<= 1) v += __shfl_xor(v, o);
    return v;
}
__device__ __forceinline__ float bf2f(unsigned h) { return __uint_as_float(h << 16); }
__device__ __forceinline__ unsigned pk2(float lo, float hi) { return pg8::cvt_pk_bf16(lo, hi); }
__device__ __forceinline__ int rowof(int b, int pos) { return pos < NMETA ? MMAIN + pos : b * SEQ + pos - NMETA; }
#define ROW_ROR_ADD(x, n) ((x) + __builtin_bit_cast(float, __builtin_amdgcn_update_dpp(0, __builtin_bit_cast(int, (x)), 0x120 + (n), 0xf, 0xf, false)))
__device__ __forceinline__ float row16_allsum(float x) { x = ROW_ROR_ADD(x, 8); x = ROW_ROR_ADD(x, 4); x = ROW_ROR_ADD(x, 2); x = ROW_ROR_ADD(x, 1); return x; }

__device__ __forceinline__ void transpose_item(const float* __restrict__ W, int K, int N, bf16* WT, int dest_row0, const float* __restrict__ gain, LAS float* scr, int k0, int n0, int lane) {
    const int c4 = 4 * (lane & 7), r8 = lane >> 3;
    f32x4 v[8]; float g[8];
#pragma unroll
    for (int i = 0; i < 8; ++i) { const int kk = r8 + 8 * i; v[i] = __builtin_nontemporal_load((const f32x4*)(W + (size_t)(k0 + kk) * N + n0 + c4)); g[i] = gain ? gain[k0 + kk] : 1.0f; }
#pragma unroll
    for (int i = 0; i < 8; ++i) { const int kk = r8 + 8 * i; LAS float* d = scr + kk * 33 + c4; d[0] = v[i][0] * g[i]; d[1] = v[i][1] * g[i]; d[2] = v[i][2] * g[i]; d[3] = v[i][3] * g[i]; }
    LDS_WAIT(); asm volatile("" ::: "memory");
    const int c = lane & 7;
#pragma unroll
    for (int j = 0; j < 4; ++j) { const int n = (lane >> 3) + 8 * j; const LAS float* s = scr + (8 * c) * 33 + n;
        u32x4 o; o.x = pk2(s[0 * 33], s[1 * 33]); o.y = pk2(s[2 * 33], s[3 * 33]); o.z = pk2(s[4 * 33], s[5 * 33]); o.w = pk2(s[6 * 33], s[7 * 33]);
        *(u32x4*)(WT + (size_t)(dest_row0 + n) * K + k0 + 8 * c) = o; }
    LDS_WAIT(); asm volatile("" ::: "memory");
}
__device__ __forceinline__ void mat_item(const float* W, int K, int N, bf16* WT, int mode, const float* gain, LAS float* scr, int r, int lane) {
    const int nblk = N / 32, kb = r / nblk, nb = r % nblk, k0 = 64 * kb, n0 = 32 * nb;
    const int dest = mode == 0 ? n0 : (256 * (n0 / 128) + (n0 % 128) + (mode == 2 ? 128 : 0));
    transpose_item(W, K, N, WT, dest, gain, scr, k0, n0, lane);
}
__device__ __forceinline__ void rms_row_to_bf16(const float* src, bf16* dst, int lane) {
    f32x4 v[4]; float s = 0.f;
#pragma unroll
    for (int j = 0; j < 4; ++j) { v[j] = src ? ((const f32x4*)src)[lane + 64 * j] : (f32x4){0.f, 0.f, 0.f, 0.f}; s += (v[j].x * v[j].x + v[j].y * v[j].y) + (v[j].z * v[j].z + v[j].w * v[j].w); }
    const float rstd = __builtin_amdgcn_rsqf(wave_sum(s) * (1.0f / 1024.0f) + 1e-6f);
#pragma unroll
    for (int j = 0; j < 4; ++j) { u32x2 o; o.x = pk2(v[j].x * rstd, v[j].y * rstd); o.y = pk2(v[j].z * rstd, v[j].w * rstd); ((u32x2*)dst)[lane + 64 * j] = o; }
}
__device__ __forceinline__ void conv_set(const Params& P, LAS unsigned char* lds, int set, int w, int nw, int wid, int lane) {
    LAS float* scr = (LAS float*)(lds + wid * 8704);
    unsigned char* ws = P.ws;
    constexpr int I_G = 16 * 88, I_D = 44 * 32, I_IN = 16 * 104, I_O = 16 * 32, I_L = 16, I_LG2 = 32;
    const int nit = set == 0 ? 2 * I_G + 2 * I_L + I_LG2 : (set == 1 ? I_D + I_IN : (set == 2 ? I_O + 2 * I_G : I_D));
    for (int it = w; it < nit; it += nw) {
        int r = it;
        if (set == 0) {
            if (r < I_G) { mat_item(P.in[I_F1G], 1024, DFF, (bf16*)(ws + OFF_WGU1), 1, P.in[I_F1N], scr, r, lane); continue; } r -= I_G;
            if (r < I_G) { mat_item(P.in[I_F1U], 1024, DFF, (bf16*)(ws + OFF_WGU1), 2, P.in[I_F1N], scr, r, lane); continue; } r -= I_G;
            if (r < I_L) { mat_item(P.in[I_WUP], 64, 512, (bf16*)(ws + OFF_LW), 0, nullptr, scr, r, lane); continue; } r -= I_L;
            if (r < I_L) { mat_item(P.in[I_AUP], 64, 512, (bf16*)(ws + OFF_LA), 0, nullptr, scr, r, lane); continue; } r -= I_L;
            mat_item(P.in[I_GUP], 128, 512, (bf16*)(ws + OFF_LG), 0, nullptr, scr, r, lane);
        } else if (set == 1) {
            if (r < I_D) { mat_item(P.in[I_F1D], DFF, 1024, (bf16*)(ws + OFF_WD1), 0, nullptr, scr, r, lane); continue; } r -= I_D;
            mat_item(P.in[I_WIN], 1024, INC, (bf16*)(ws + OFF_WIN), 0, P.in[I_MIXN], scr, r, lane);
        } else if (set == 2) {
            if (r < I_O) { mat_item(P.in[I_WOUT], 1024, 1024, (bf16*)(ws + OFF_WOUT), 0, nullptr, scr, r, lane); continue; } r -= I_O;
            if (r < I_G) { mat_item(P.in[I_F2G], 1024, DFF, (bf16*)(ws + OFF_WGU2), 1, P.in[I_F2N], scr, r, lane); continue; } r -= I_G;
            mat_item(P.in[I_F2U], 1024, DFF, (bf16*)(ws + OFF_WGU2), 2, P.in[I_F2N], scr, r, lane);
        } else {
            mat_item(P.in[I_F2D], DFF, 1024, (bf16*)(ws + OFF_WD2), 0, nullptr, scr, r, lane);
        }
    }
}
__device__ __forceinline__ void conv_idle(const Params& P, LAS unsigned char* lds, int set, int nwg, int G, int wid, int lane) {
    const int c0 = nwg % G; if ((int)blockIdx.x < c0) return;
    conv_set(P, lds, set, ((int)blockIdx.x - c0) * NWAVES + wid, (G - c0) * NWAVES, wid, lane);
}
__device__ __forceinline__ void p0_prologue(const Params& P, LAS unsigned char* lds, int gw, int NGW, int wid, int lane) {
    unsigned char* ws = P.ws;
    conv_set(P, lds, 0, gw, NGW, wid, lane);
    { float* zz = (float*)(ws + OFF_SS1); for (int i = gw * 64 + lane; i < 2 * 16640; i += NGW * 64) zz[i] = 0.f; }
    bf16* A1 = (bf16*)(ws + OFF_RA);
    for (int m0 = 4 * gw; m0 < MALL; m0 += 4 * NGW) {
        f32x4 v[4][4]; float ss[4];
#pragma unroll
        for (int r = 0; r < 4; ++r) { const int m = m0 + r;
            const float* src = m < MMAIN ? P.in[I_X] + (size_t)m * DM : (m < MVALID ? P.in[I_META] + (size_t)(m - MMAIN) * DM : nullptr);
#pragma unroll
            for (int j = 0; j < 4; ++j) v[r][j] = src ? __builtin_nontemporal_load((const f32x4*)src + lane + 64 * j) : (f32x4){0.f, 0.f, 0.f, 0.f}; }
#pragma unroll
        for (int r = 0; r < 4; ++r) { float s = 0.f;
#pragma unroll
            for (int j = 0; j < 4; ++j) s += (v[r][j].x * v[r][j].x + v[r][j].y * v[r][j].y) + (v[r][j].z * v[r][j].z + v[r][j].w * v[r][j].w);
            s = row16_allsum(s); s += __shfl_xor(s, 16); s += __shfl_xor(s, 32); ss[r] = s; }
#pragma unroll
        for (int r = 0; r < 4; ++r) { const float ms = ss[r] * (1.0f / 1024.0f) + 1e-6f; const float rstd = __builtin_amdgcn_rsqf(ms); bf16* dst = A1 + (size_t)(m0 + r) * DM;
            if (lane == 0) ((float*)(ws + OFF_RMS0))[m0 + r] = ms * rstd;
#pragma unroll
            for (int j = 0; j < 4; ++j) { u32x2 o; o.x = pk2(v[r][j].x * rstd, v[r][j].y * rstd); o.y = pk2(v[r][j].z * rstd, v[r][j].w * rstd); ((u32x2*)dst)[lane + 64 * j] = o; } }
    }
}
#define XB_TMO      128
#define XB_XCNT(j)  (256  + 64 * (j))
#define XB_XSUB(j)  (1280 + 64 * (j))
#define XB_XGEN(j)  (2304 + 64 * (j))
#define XB_TOP      3328
#define XB_TOPGEN   3392
#define XCD_BAR_WORDS 3456
#define XB_SPIN_CAP (1u << 18)

__device__ __forceinline__ unsigned xb_ld(unsigned* p)              { return __hip_atomic_load(p, __ATOMIC_RELAXED, __HIP_MEMORY_SCOPE_AGENT); }
__device__ __forceinline__ unsigned xb_add(unsigned* p, unsigned v) { return __hip_atomic_fetch_add(p, v, __ATOMIC_RELAXED, __HIP_MEMORY_SCOPE_AGENT); }
__device__ __forceinline__ unsigned xb_xcc_id() { return (unsigned)__builtin_amdgcn_s_getreg((3 << 11) | 20) & 0xFu; }
#define XB_SPIN(cond, bar) do { unsigned _sp = 0; while (cond) { __builtin_amdgcn_s_sleep(1); \
    if ((++_sp & 255u) == 0u) { if (xb_ld(&(bar)[XB_TMO])) break; if (_sp > XB_SPIN_CAP) { atomicAdd(&(bar)[XB_TMO], 1u); break; } } } } while (0)

struct XcdBarrier {
    unsigned* bar; unsigned x;
    volatile LAS unsigned* st;
};

__device__ __forceinline__ XcdBarrier xcd_barrier_post(unsigned* bar, volatile LAS unsigned* st) {
    XcdBarrier b; b.bar = bar; b.x = xb_xcc_id(); b.st = st;
    if (threadIdx.x == 0) (void)xb_add(&bar[XB_XCNT(b.x)], 1u);
    return b;
}
__device__ __forceinline__ void xcd_barrier_complete(unsigned* bar, unsigned x, unsigned& nloc, unsigned& nx) {
    const unsigned G = gridDim.x * gridDim.y * gridDim.z;
    unsigned sum, cnt, mine, sp = 0u;
    for (;;) {
        sum = 0u; cnt = 0u; mine = 0u;
#pragma unroll
        for (unsigned j = 0; j < 16; ++j) { const unsigned c = xb_ld(&bar[XB_XCNT(j)]); sum += c; cnt += (c > 0u) ? 1u : 0u; mine = (j == x) ? c : mine; }
        if (sum == G) break;
        __builtin_amdgcn_s_sleep(1);
        if ((++sp & 255u) == 0u) { if (xb_ld(&bar[XB_TMO])) break; if (sp > XB_SPIN_CAP) { atomicAdd(&bar[XB_TMO], 1u); break; } }
    }
    nloc = mine > 0u ? mine : 1u; nx = cnt > 0u ? cnt : 1u;
}

__device__ __forceinline__ void xcd_barrier(const XcdBarrier& b) {
    asm volatile("s_waitcnt vmcnt(0)" ::: "memory");
    __syncthreads();
    if (threadIdx.x == 0) {
        unsigned* bar = b.bar;
        __builtin_amdgcn_s_waitcnt(0);
        unsigned nloc = b.st[0], nx = b.st[1];
        if (nloc == 0u) { xcd_barrier_complete(bar, b.x, nloc, nx); b.st[0] = nloc; b.st[1] = nx; }
        const unsigned old = xb_add(&bar[XB_XSUB(b.x)], 1u);
        const unsigned gen = old / nloc;
        if (old + 1u == (gen + 1u) * nloc) {
            __builtin_amdgcn_fence(__ATOMIC_RELEASE, "agent");
            asm volatile("s_waitcnt vmcnt(0)" ::: "memory");
            const unsigned og = xb_add(&bar[XB_TOP], 1u);
            const unsigned tg = og / nx;
            if (og + 1u == (tg + 1u) * nx) xb_add(&bar[XB_TOPGEN], 1u);
            else XB_SPIN(xb_ld(&bar[XB_TOPGEN]) == tg, bar);
            __builtin_amdgcn_fence(__ATOMIC_ACQUIRE, "agent");
            xb_add(&bar[XB_XGEN(b.x)], 1u);
            asm volatile("s_waitcnt vmcnt(0)" ::: "memory");
        } else {
            XB_SPIN(xb_ld(&bar[XB_XGEN(b.x)]) == gen, bar);
            __builtin_amdgcn_fence(__ATOMIC_ACQUIRE, "agent");
            asm volatile("s_waitcnt vmcnt(0)" ::: "memory");
        }
    }
    __syncthreads();
}

__device__ __forceinline__ f32x4 meta_tile(const bf16* __restrict__ A, int lda, const bf16* __restrict__ Brow, int K, int lane) {
    const int fr = lane & 15, fq = lane >> 4; const bf16* ap = A + (size_t)fr * lda + 8 * fq; const bf16* bp = Brow + (size_t)fr * K + 8 * fq;
    f32x4 acc = (f32x4){0.f, 0.f, 0.f, 0.f};
#pragma unroll 8
    for (int k = 0; k < K; k += 32) acc = __builtin_amdgcn_mfma_f32_16x16x32_bf16(*(const bf16x8*)(bp + k), *(const bf16x8*)(ap + k), acc, 0, 0, 0);
    return acc;
}
__device__ __forceinline__ int meta_task(int t_per_block_wave, int wid, int G) { return (G - 1 - (int)blockIdx.x) * NWAVES + wid; }
__device__ __forceinline__ void meta_gu1(const Params& P, int wid, int G, int lane) {
    const int fr = lane & 15, fq = lane >> 4; unsigned char* ws = P.ws;
    const bf16* A = (const bf16*)(ws + OFF_RA) + (size_t)MMAIN * DM; const bf16* W = (const bf16*)(ws + OFF_WGU1); bf16* ACT = (bf16*)(ws + OFF_ACT);
    for (int t = meta_task(0, wid, G); t < DFF / 16; t += G * NWAVES) {
        const int n0 = 16 * t; const bf16* gr = W + (size_t)(256 * (n0 / 128) + (n0 % 128)) * DM;
        const f32x4 g = meta_tile(A, DM, gr, DM, lane), u = meta_tile(A, DM, gr + (size_t)128 * DM, DM, lane);
        u32x2 w; w.x = pk2(pg8::silu_f(g[0]) * u[0], pg8::silu_f(g[1]) * u[1]); w.y = pk2(pg8::silu_f(g[2]) * u[2], pg8::silu_f(g[3]) * u[3]);
        *(u32x2*)(ACT + (size_t)(MMAIN + fr) * DFF + n0 + 4 * fq) = w;
    }
}
__device__ __forceinline__ void meta_d1(const Params& P, LAS unsigned char* lds, int wid, int G, int lane) {
    const int fr = lane & 15, fq = lane >> 4; unsigned char* ws = P.ws;
    const bf16* A = (const bf16*)(ws + OFF_ACT) + (size_t)MMAIN * DFF; const bf16* W = (const bf16*)(ws + OFF_WD1); bf16* HB = (bf16*)(ws + OFF_RA); float* ss1 = (float*)(ws + OFF_SS1);
    LAS f32x4* part = (LAS f32x4*)lds;
    for (int t = (int)blockIdx.x; t < DM / 16; t += G) {
        const int n0 = 16 * t, k0 = wid * (DFF / NWAVES);
        const bf16* ap = A + (size_t)fr * DFF + k0 + 8 * fq; const bf16* bp = W + (size_t)(n0 + fr) * DFF + k0 + 8 * fq;
        f32x4 acc = (f32x4){0.f, 0.f, 0.f, 0.f};
#pragma unroll
        for (int k = 0; k < DFF / NWAVES; k += 32) acc = __builtin_amdgcn_mfma_f32_16x16x32_bf16(*(const bf16x8*)(bp + k), *(const bf16x8*)(ap + k), acc, 0, 0, 0);
        part[wid * 64 + lane] = acc;
        __syncthreads();
        if (wid == 0) {
            f32x4 a = part[lane];
#pragma unroll
            for (int w = 1; w < NWAVES; ++w) a = a + part[w * 64 + lane];
            const f32x4 o = *(const f32x4*)(P.in[I_META] + (size_t)fr * DM + n0 + 4 * fq) + a * 0.5f;
            u32x2 w2; w2.x = pk2(o[0], o[1]); w2.y = pk2(o[2], o[3]); *(u32x2*)(HB + (size_t)(MMAIN + fr) * DM + n0 + 4 * fq) = w2;
            float ss = (o[0] * o[0] + o[1] * o[1]) + (o[2] * o[2] + o[3] * o[3]); ss += __shfl_xor(ss, 16); ss += __shfl_xor(ss, 32);
            if (fq == 0) atomicAdd(ss1 + MMAIN + fr, ss);
        }
        __syncthreads();
    }
}
__device__ __forceinline__ void meta_win(const Params& P, int wid, int G, int lane) {
    const int fr = lane & 15, fq = lane >> 4; unsigned char* ws = P.ws;
    const bf16* A = (const bf16*)(ws + OFF_RA) + (size_t)MMAIN * DM; const bf16* W = (const bf16*)(ws + OFF_WIN); bf16* PB = (bf16*)(ws + OFF_RB); const float* ss1 = (const float*)(ws + OFF_SS1);
    for (int t = meta_task(0, wid, G); t < INC / 16; t += G * NWAVES) {
        const int n0 = 16 * t; f32x4 a = meta_tile(A, DM, W + (size_t)n0 * DM, DM, lane);
        a = a * __builtin_amdgcn_rsqf(ss1[MMAIN + fr] * (1.0f / 1024.0f) + 1e-6f);
        const int pt = n0 >= 3072 ? 6 : (n0 >> 9), ld = pt == 6 ? 256 : 512, colt = n0 - (pt == 6 ? 3072 : (pt << 9));
        u32x2 w; w.x = pk2(a[0], a[1]); w.y = pk2(a[2], a[3]); *(u32x2*)(PB + (size_t)pt * PIECE_E + (size_t)(MMAIN + fr) * ld + colt + 4 * fq) = w;
    }
}

constexpr float QSCALE = 0.125f * 1.44269504f;
__device__ __forceinline__ u32x4 qk_norm_vals(u32x4 raw, const float* __restrict__ gain, float scale, int lane) {
    float x[8];
#pragma unroll
    for (int i = 0; i < 4; ++i) { x[2 * i] = bf2f(raw[i] & 0xffffu); x[2 * i + 1] = bf2f(raw[i] >> 16); }
    float ss = 0.f;
#pragma unroll
    for (int i = 0; i < 8; ++i) ss += x[i] * x[i];
    ss += __shfl_xor(ss, 1); ss += __shfl_xor(ss, 2); ss += __shfl_xor(ss, 4);
    const float rstd = scale * __builtin_amdgcn_rsqf(ss * (1.0f / 64.0f) + 1e-6f);
    const f32x4 g0 = *(const f32x4*)(gain + 8 * (lane & 7)), g1 = *(const f32x4*)(gain + 8 * (lane & 7) + 4);
    u32x4 o; o.x = pk2(x[0] * rstd * g0[0], x[1] * rstd * g0[1]); o.y = pk2(x[2] * rstd * g0[2], x[3] * rstd * g0[3]);
    o.z = pk2(x[4] * rstd * g1[0], x[5] * rstd * g1[1]); o.w = pk2(x[6] * rstd * g1[2], x[7] * rstd * g1[3]);
    return o;
}
__device__ __forceinline__ void prepA_phase(const Params& P, int gw, int wid, int G, int NGW, int lane) {
    bf16* PQ = (bf16*)(P.ws + OFF_PQ); bf16* PK = (bf16*)(P.ws + OFF_PK); const bf16* PV = (const bf16*)(P.ws + OFF_PV); bf16* Vt = (bf16*)(P.ws + OFF_VT);
    for (int row0 = 4 * gw; row0 < MVALID; row0 += 4 * NGW) {
        u32x4 rk[4];
#pragma unroll
        for (int r = 0; r < 4; ++r) rk[r] = *(const u32x4*)(PK + (size_t)(row0 + r) * 512 + 8 * lane);
#pragma unroll
        for (int r = 0; r < 4; ++r) *(u32x4*)(PK + (size_t)(row0 + r) * 512 + 8 * lane) = qk_norm_vals(rk[r], P.in[I_KN], 1.0f, lane);
    }
    for (int it = wid * G + (int)blockIdx.x; it < 32 * 33; it += NGW) {
        const int bh = it / 33, j = it % 33, b = bh >> 2, hh = bh & 3, pos = 64 * j + lane; const bool valid = pos < LPOS;
        const int row = rowof(b, valid ? pos : 0);
        const u32x4* src = (const u32x4*)(PV + (size_t)row * 512 + hh * 128);
        u32x4 v[16];
#pragma unroll
        for (int i = 0; i < 16; ++i) v[i] = valid ? src[i] : (u32x4){0u, 0u, 0u, 0u};
        bf16* dst = Vt + (size_t)bh * 128 * VT_LD + pos;
#pragma unroll
        for (int i = 0; i < 16; ++i)
#pragma unroll
            for (int jj = 0; jj < 8; ++jj) { const unsigned w = v[i][jj >> 1]; dst[(size_t)(8 * i + jj) * VT_LD] = (bf16)((jj & 1) ? (w >> 16) : (w & 0xffffu)); }
    }
}

__device__ __forceinline__ void att_qk(const LAS unsigned char* Kb, const bf16x8 (&qf)[2][2], int nst, int j, int qpos, float slope2, int fr, int fq, f32x4 (&sc)[2][4]) {
    constexpr int KSTR = 272;
#pragma unroll
    for (int st = 0; st < 4; ++st) {
        if (st < nst) {
            const float d0 = (float)(qpos - (64 * j + 16 * st + 4 * fq));
            f32x4 s0;
#pragma unroll
            for (int e = 0; e < 4; ++e) s0[e] = -slope2 * __builtin_fabsf(d0 - (float)e) - 12.0f;
            f32x4 s1 = s0;
#pragma unroll
            for (int ks = 0; ks < 2; ++ks) {
                const bf16x8 k0 = *(const LAS bf16x8*)(Kb + (16 * st + fr) * KSTR + (32 * ks + 8 * fq) * 2);
                const bf16x8 k1 = *(const LAS bf16x8*)(Kb + (16 * st + fr) * KSTR + (64 + 32 * ks + 8 * fq) * 2);
                s0 = __builtin_amdgcn_mfma_f32_16x16x32_bf16(k0, qf[0][ks], s0, 0, 0, 0);
                s1 = __builtin_amdgcn_mfma_f32_16x16x32_bf16(k1, qf[1][ks], s1, 0, 0, 0);
            }
            sc[0][st] = s0; sc[1][st] = s1;
        }
    }
}
__device__ __forceinline__ void att_pv(const LAS unsigned char* Vb, int nst, const f32x4 (&sc)[2][4], f32x4 (&O)[2][8], float& l0, float& l1, int fr, int fq) {
    constexpr int VSTR = 144;
    if (nst <= 0) return;
    unsigned pw[2][4][2];
#pragma unroll
    for (int st = 0; st < 4; ++st) {
        if (st < nst) {
            float p0[4], p1[4];
#pragma unroll
            for (int e = 0; e < 4; ++e) { p0[e] = __builtin_amdgcn_exp2f(sc[0][st][e]); p1[e] = __builtin_amdgcn_exp2f(sc[1][st][e]); l0 += p0[e]; l1 += p1[e]; }
            pw[0][st][0] = pk2(p0[0], p0[1]); pw[0][st][1] = pk2(p0[2], p0[3]); pw[1][st][0] = pk2(p1[0], p1[1]); pw[1][st][1] = pk2(p1[2], p1[3]);
        } else { pw[0][st][0] = 0u; pw[0][st][1] = 0u; pw[1][st][0] = 0u; pw[1][st][1] = 0u; }
    }
#pragma unroll
    for (int ks2 = 0; ks2 < 2; ++ks2) {
        if (ks2 == 0 || nst == 4) {
            const u32x4 a0 = (u32x4){pw[0][2 * ks2][0], pw[0][2 * ks2][1], pw[0][2 * ks2 + 1][0], pw[0][2 * ks2 + 1][1]};
            const u32x4 a1 = (u32x4){pw[1][2 * ks2][0], pw[1][2 * ks2][1], pw[1][2 * ks2 + 1][0], pw[1][2 * ks2 + 1][1]};
            const bf16x8 pf0 = __builtin_bit_cast(bf16x8, a0), pf1 = __builtin_bit_cast(bf16x8, a1);
#pragma unroll
            for (int dt = 0; dt < 8; ++dt) {
                const LAS unsigned char* vp = Vb + (16 * dt + fr) * VSTR + (32 * ks2 + 4 * fq) * 2;
                const u32x2 va = *(const LAS u32x2*)vp, vb2 = *(const LAS u32x2*)(vp + 32);
                const bf16x8 vf = __builtin_bit_cast(bf16x8, (u32x4){va.x, va.y, vb2.x, vb2.y});
                O[0][dt] = __builtin_amdgcn_mfma_f32_16x16x32_bf16(vf, pf0, O[0][dt], 0, 0, 0);
                O[1][dt] = __builtin_amdgcn_mfma_f32_16x16x32_bf16(vf, pf1, O[1][dt], 0, 0, 0);
            }
        }
    }
}
__device__ __forceinline__ void attn_phase(const Params& P, LAS unsigned char* lds, int tid, int wid, int lane) {
    const int fr = lane & 15, fq = lane >> 4;
    const bf16* PQ = (const bf16*)(P.ws + OFF_PQ); const bf16* PK = (const bf16*)(P.ws + OFF_PK); const bf16* Vt = (const bf16*)(P.ws + OFF_VT); bf16* CAT = (bf16*)(P.ws + OFF_RA);
    float lam; { const float* lv = P.in[I_LAMV]; float a = lv[lane] * lv[64 + lane], c = lv[128 + lane] * lv[192 + lane]; a = wave_sum(a); c = wave_sum(c); lam = __expf(a) - __expf(c) + 0.2f; }
    constexpr int KSTR = 272, VSTR = 144, KBUF = 64 * KSTR, VBUF = 128 * VSTR, VOFF = 2 * KBUF;
    const int kr = tid >> 3, kseg = tid & 7, vr = tid >> 2, vseg = tid & 3;
    const int vcu_ = (gridDim.x % 8 == 0) ? ((int)blockIdx.x % 8) * ((int)gridDim.x / 8) + (int)blockIdx.x / 8 : (int)blockIdx.x;
    for (int it = vcu_; it < 512; it += gridDim.x) {
        const int i2 = it & 255, hi = it >> 8, bh = i2 >> 3, cpl = i2 & 7, cp = hi ? 15 - cpl : cpl, b = bh >> 2, hh = bh & 3;
        const int c = 2 * cp + (wid >> 2), qframe = 128 * cp + 16 * wid + fr, qpos = qframe + NMETA, nt = 2 * cp + 3;
        const float slope2 = 1.44269504f * __builtin_amdgcn_exp2f(-2.0f * (float)(hh + 1));
        const bf16* qrow = PQ + (size_t)(b * SEQ + qframe) * 512 + hh * 128;
        bf16x8 qf[2][2];
#pragma unroll
        for (int cm = 0; cm < 2; ++cm)
#pragma unroll
            for (int ks = 0; ks < 2; ++ks) qf[cm][ks] = *(const bf16x8*)(qrow + 64 * cm + 32 * ks + 8 * fq);
#pragma unroll
        for (int cm = 0; cm < 2; ++cm) {
            float x[2][8]; float ss = 0.f;
#pragma unroll
            for (int ks = 0; ks < 2; ++ks) { const u32x4 raw = __builtin_bit_cast(u32x4, qf[cm][ks]);
#pragma unroll
                for (int i = 0; i < 4; ++i) { x[ks][2 * i] = bf2f(raw[i] & 0xffffu); x[ks][2 * i + 1] = bf2f(raw[i] >> 16); ss += x[ks][2 * i] * x[ks][2 * i] + x[ks][2 * i + 1] * x[ks][2 * i + 1]; } }
            ss += __shfl_xor(ss, 16); ss += __shfl_xor(ss, 32);
            const float rq_ = QSCALE * __builtin_amdgcn_rsqf(ss * (1.0f / 64.0f) + 1e-6f);
#pragma unroll
            for (int ks = 0; ks < 2; ++ks) { const f32x4 g0 = *(const f32x4*)(P.in[I_QN] + 32 * ks + 8 * fq), g1 = *(const f32x4*)(P.in[I_QN] + 32 * ks + 8 * fq + 4);
                const u32x4 w = (u32x4){pk2(x[ks][0] * rq_ * g0[0], x[ks][1] * rq_ * g0[1]), pk2(x[ks][2] * rq_ * g0[2], x[ks][3] * rq_ * g0[3]), pk2(x[ks][4] * rq_ * g1[0], x[ks][5] * rq_ * g1[1]), pk2(x[ks][6] * rq_ * g1[2], x[ks][7] * rq_ * g1[3])};
                qf[cm][ks] = __builtin_bit_cast(bf16x8, w); }
        }
        f32x4 O[2][8];
#pragma unroll
        for (int cm = 0; cm < 2; ++cm)
#pragma unroll
            for (int dt = 0; dt < 8; ++dt) O[cm][dt] = (f32x4){0.f, 0.f, 0.f, 0.f};
        float l0 = 0.f, l1 = 0.f;
        u32x4 ak0, ak1, av0, av1;
#define ATT_LOADK(S, j) do { int pos_ = 64 * (j) + kr; pos_ = pos_ < LPOS ? pos_ : LPOS - 1; const bf16* kp_ = PK + (size_t)rowof(b, pos_) * 512 + hh * 128 + 8 * kseg; S##k0 = *(const u32x4*)kp_; S##k1 = *(const u32x4*)(kp_ + 64); } while (0)
#define ATT_LOADV(S, j) do { const bf16* vp_ = Vt + ((size_t)bh * 128 + vr) * VT_LD + 64 * (j) + 8 * vseg; S##v0 = *(const u32x4*)vp_; S##v1 = *(const u32x4*)(vp_ + 32); } while (0)
#define ATT_WRITEK(S, buf) do { LAS unsigned char* kb_ = lds + (buf) * KBUF + kr * KSTR + kseg * 16; *(LAS u32x4*)kb_ = S##k0; *(LAS u32x4*)(kb_ + 128) = S##k1; } while (0)
#define ATT_WRITEV(S, buf) do { LAS unsigned char* vb_ = lds + VOFF + (buf) * VBUF + vr * VSTR + vseg * 16; *(LAS u32x4*)vb_ = S##v0; *(LAS u32x4*)(vb_ + 64) = S##v1; } while (0)
#define ATT_BAR() do { asm volatile("s_waitcnt lgkmcnt(0)" ::: "memory"); __builtin_amdgcn_s_barrier(); asm volatile("" ::: "memory"); } while (0)
#define ATT_NST(j) (((j) <= c) ? 4 : ((j) == c + 1 ? 1 : 0))
        __syncthreads();
        ATT_LOADK(a, 0); ATT_LOADV(a, 0); ATT_WRITEK(a, 0); ATT_WRITEV(a, 0);
        if (nt > 1) { ATT_LOADK(a, 1); ATT_WRITEK(a, 1); }
        __syncthreads();
        f32x4 scA[2][4], scB[2][4];
        att_qk(lds, qf, ATT_NST(0), 0, qpos, slope2, fr, fq, scA);
        for (int j = 0; j < nt; j += 2) {
            if (j + 1 < nt) { if (j + 2 < nt) ATT_LOADK(a, j + 2); ATT_LOADV(a, j + 1); }
            if (j + 1 < nt) att_qk(lds + KBUF, qf, ATT_NST(j + 1), j + 1, qpos, slope2, fr, fq, scB);
            att_pv(lds + VOFF, ATT_NST(j), scA, O, l0, l1, fr, fq);
            if (j + 1 < nt) { if (j + 2 < nt) ATT_WRITEK(a, 0); ATT_WRITEV(a, 1); }
            ATT_BAR();
            if (j + 1 >= nt) break;
            if (j + 2 < nt) { if (j + 3 < nt) ATT_LOADK(a, j + 3); ATT_LOADV(a, j + 2); }
            if (j + 2 < nt) att_qk(lds, qf, ATT_NST(j + 2), j + 2, qpos, slope2, fr, fq, scA);
            att_pv(lds + VOFF + VBUF, ATT_NST(j + 1), scB, O, l0, l1, fr, fq);
            if (j + 2 < nt) { if (j + 3 < nt) ATT_WRITEK(a, 1); ATT_WRITEV(a, 0); }
            ATT_BAR();
        }
#undef ATT_LOADK
#undef ATT_LOADV
#undef ATT_WRITEK
#undef ATT_WRITEV
#undef ATT_BAR
#undef ATT_NST
        l0 += __shfl_xor(l0, 16); l0 += __shfl_xor(l0, 32); l1 += __shfl_xor(l1, 16); l1 += __shfl_xor(l1, 32);
        const float inv0 = __builtin_amdgcn_rcpf(l0), inv1 = lam * __builtin_amdgcn_rcpf(l1); float ss = 0.f;
#pragma unroll
        for (int dt = 0; dt < 8; ++dt) { O[0][dt] = O[0][dt] * inv0 - O[1][dt] * inv1; ss += (O[0][dt][0] * O[0][dt][0] + O[0][dt][1] * O[0][dt][1]) + (O[0][dt][2] * O[0][dt][2] + O[0][dt][3] * O[0][dt][3]); }
        ss += __shfl_xor(ss, 16); ss += __shfl_xor(ss, 32);
        const float rstd = 0.8f * __builtin_amdgcn_rsqf(ss * (1.0f / 128.0f) + 1e-6f);
        bf16* orow = CAT + (size_t)(b * SEQ + qframe) * 1024 + hh * 128 + 4 * fq; const float* og = P.in[I_AON] + 4 * fq;
#pragma unroll
        for (int dt = 0; dt < 8; ++dt) { const f32x4 g = *(const f32x4*)(og + 16 * dt); u32x2 o; o.x = pk2(O[0][dt][0] * rstd * g[0], O[0][dt][1] * rstd * g[1]); o.y = pk2(O[0][dt][2] * rstd * g[2], O[0][dt][3] * rstd * g[3]);
            *(u32x2*)(orow + 16 * dt) = o; }
    }
}
__device__ __forceinline__ void ld8(const bf16* p, bool ok, float (&x)[8]) {
    u32x4 raw = ok ? *(const u32x4*)p : (u32x4){0u, 0u, 0u, 0u};
#pragma unroll
    for (int i = 0; i < 4; ++i) { x[2 * i] = bf2f(raw[i] & 0xffffu); x[2 * i + 1] = bf2f(raw[i] >> 16); }
}
__device__ __forceinline__ void ld4(const bf16* p, bool ok, float (&x)[4]) {
    u32x2 raw = ok ? *(const u32x2*)p : (u32x2){0u, 0u};
    x[0] = bf2f(raw.x & 0xffffu); x[1] = bf2f(raw.x >> 16); x[2] = bf2f(raw.y & 0xffffu); x[3] = bf2f(raw.y >> 16);
}
__device__ __forceinline__ void lerp4(const bf16* base, int row, int prow, int col, const float* __restrict__ mu, float (&x)[4]) {
    float p[4], pp[4]; ld4(base + (size_t)row * 512 + col, true, p); ld4(base + (size_t)(prow < 0 ? 0 : prow) * 512 + col, prow >= 0, pp);
    const f32x4 m = *(const f32x4*)(mu + col);
#pragma unroll
    for (int e = 0; e < 4; ++e) x[e] = p[e] + (pp[e] - p[e]) * m[e];
}
__device__ __forceinline__ u32x4 pkh8(const float (&x)[8]) { typedef _Float16 h16x8 __attribute__((ext_vector_type(8))); h16x8 h = (h16x8){(h16)x[0], (h16)x[1], (h16)x[2], (h16)x[3], (h16)x[4], (h16)x[5], (h16)x[6], (h16)x[7]}; return __builtin_bit_cast(u32x4, h); }
__device__ __forceinline__ u32x2 pkh4(float a, float b, float c, float d) { h16x4 h = (h16x4){(h16)a, (h16)b, (h16)c, (h16)d}; return __builtin_bit_cast(u32x2, h); }
__device__ __forceinline__ void prepR_phase(const Params& P, int wid, int G, int NGW, int lane) {
    const int fr = lane & 15, fq = lane >> 4; unsigned char* ws = P.ws;
    const bf16* PR = (const bf16*)(ws + OFF_PR); const bf16* PKR = (const bf16*)(ws + OFF_PKR); const bf16* PVR = (const bf16*)(ws + OFF_PVR); const bf16* PX = (const bf16*)(ws + OFF_PX);
    const bf16* LW = (const bf16*)(ws + OFF_LW); const bf16* LA = (const bf16*)(ws + OFF_LA); const bf16* LG = (const bf16*)(ws + OFF_LG);
    h16* SR = (h16*)(ws + OFF_SR); h16* SK = (h16*)(ws + OFF_SK); h16* SKK = (h16*)(ws + OFF_SKK); h16* SB = (h16*)(ws + OFF_SB); h16* SE = (h16*)(ws + OFF_SE); h16* SV = (h16*)(ws + OFF_SV); h16* SG = (h16*)(ws + OFF_SG);
    float* BON = (float*)(ws + OFF_BONUS);
    const float* mu = P.in[I_MU];
    for (int it = wid * G + (int)blockIdx.x; it < (MMAIN / 16) * 2 + 8; it += NGW) {
        const bool mt = it >= (MMAIN / 16) * 2; const int h0 = mt ? it - (MMAIN / 16) * 2 : 4 * (it & 1), nh = mt ? 1 : 4; const int row_raw = (mt ? MMAIN : 16 * (it >> 1)) + fr; const bool valid = row_raw < MVALID; const int row = valid ? row_raw : 0;
        const int prow = (row >= MMAIN) ? (row == MMAIN ? -1 : row - 1) : ((row & (SEQ - 1)) == 0 ? MVALID - 1 : row - 1);
        bf16x8 xwf[2], xaf[2], xgf[4];
#pragma unroll
        for (int ks = 0; ks < 8; ++ks) {
            const int col = 32 * ks + 8 * fq; float p[8], pp[8]; ld8(PX + (size_t)row * 256 + col, true, p); ld8(PX + (size_t)(prow < 0 ? 0 : prow) * 256 + col, prow >= 0, pp);
            const f32x4 m0 = *(const f32x4*)(mu + 1536 + col), m1 = *(const f32x4*)(mu + 1536 + col + 4); float x[8];
#pragma unroll
            for (int e = 0; e < 8; ++e) { const float m = e < 4 ? m0[e & 3] : m1[e & 3]; x[e] = p[e] + (pp[e] - p[e]) * m; }
            if (ks < 2) {
#pragma unroll
                for (int e = 0; e < 8; ++e) { const float t = __expf(-2.0f * __builtin_fabsf(x[e])); const float th = (1.0f - t) * __builtin_amdgcn_rcpf(1.0f + t); x[e] = x[e] < 0.f ? -th : th; }
            } else if (ks >= 4) {
#pragma unroll
                for (int e = 0; e < 8; ++e) x[e] = __builtin_amdgcn_rcpf(1.0f + __expf(-x[e]));
            }
            const u32x4 w = (u32x4){pk2(x[0], x[1]), pk2(x[2], x[3]), pk2(x[4], x[5]), pk2(x[6], x[7])};
            const bf16x8 f = __builtin_bit_cast(bf16x8, w);
            if (ks < 2) xwf[ks] = f; else if (ks < 4) xaf[ks - 2] = f; else xgf[ks - 4] = f;
        }
#pragma unroll 1
        for (int h = h0; h < h0 + nh; ++h) {
            f32x4 wacc[4], aacc[4], gacc[4];
#pragma unroll
            for (int nt = 0; nt < 4; ++nt) {
                wacc[nt] = (f32x4){0.f, 0.f, 0.f, 0.f}; aacc[nt] = wacc[nt]; gacc[nt] = wacc[nt];
                const int chr = h * 64 + 16 * (fr >> 2) + 4 * nt + (fr & 3);
#pragma unroll
                for (int ks = 0; ks < 2; ++ks) {
                    const bf16x8 bw = *(const bf16x8*)(LW + (size_t)chr * 64 + 32 * ks + 8 * fq), ba = *(const bf16x8*)(LA + (size_t)chr * 64 + 32 * ks + 8 * fq);
                    wacc[nt] = __builtin_amdgcn_mfma_f32_16x16x32_bf16(bw, xwf[ks], wacc[nt], 0, 0, 0);
                    aacc[nt] = __builtin_amdgcn_mfma_f32_16x16x32_bf16(ba, xaf[ks], aacc[nt], 0, 0, 0);
                }
#pragma unroll
                for (int ks = 0; ks < 4; ++ks) {
                    const bf16x8 bg = *(const bf16x8*)(LG + (size_t)chr * 128 + 32 * ks + 8 * fq);
                    gacc[nt] = __builtin_amdgcn_mfma_f32_16x16x32_bf16(bg, xgf[ks], gacc[nt], 0, 0, 0);
                }
            }
            float kk[4][4], as[4][4], sskk = 0.f, bon = 0.f;
            const int col16 = h * 64 + 16 * fq;
#pragma unroll
            for (int hf = 0; hf < 2; ++hf) {
                const int col = col16 + 8 * hf; float r8[8], k8[8], v8[8], pp[8];
                { ld8(PR + (size_t)row * 512 + col, true, r8); ld8(PR + (size_t)(prow < 0 ? 0 : prow) * 512 + col, prow >= 0, pp); const f32x4 m0 = *(const f32x4*)(mu + col), m1 = *(const f32x4*)(mu + col + 4);
#pragma unroll
                  for (int e = 0; e < 8; ++e) r8[e] += (pp[e] - r8[e]) * (e < 4 ? m0[e & 3] : m1[e & 3]); }
                { ld8(PKR + (size_t)row * 512 + col, true, k8); ld8(PKR + (size_t)(prow < 0 ? 0 : prow) * 512 + col, prow >= 0, pp); const f32x4 m0 = *(const f32x4*)(mu + 512 + col), m1 = *(const f32x4*)(mu + 512 + col + 4);
#pragma unroll
                  for (int e = 0; e < 8; ++e) k8[e] += (pp[e] - k8[e]) * (e < 4 ? m0[e & 3] : m1[e & 3]); }
                { ld8(PVR + (size_t)row * 512 + col, true, v8); ld8(PVR + (size_t)(prow < 0 ? 0 : prow) * 512 + col, prow >= 0, pp); const f32x4 m0 = *(const f32x4*)(mu + 1024 + col), m1 = *(const f32x4*)(mu + 1024 + col + 4);
#pragma unroll
                  for (int e = 0; e < 8; ++e) v8[e] += (pp[e] - v8[e]) * (e < 4 ? m0[e & 3] : m1[e & 3]); }
                float ev[8], kh[8], gg[8];
#pragma unroll
                for (int q = 0; q < 2; ++q) {
                    const int nt = 2 * hf + q;
                    const f32x4 w0 = *(const f32x4*)(P.in[I_W0] + col + 4 * q), a0 = *(const f32x4*)(P.in[I_A0] + col + 4 * q), kkw = *(const f32x4*)(P.in[I_KK] + col + 4 * q), kaw = *(const f32x4*)(P.in[I_KA] + col + 4 * q), rkw = *(const f32x4*)(P.in[I_RK] + col + 4 * q);
#pragma unroll
                    for (int e = 0; e < 4; ++e) {
                        const int i8 = 4 * q + e;
                        const float xs = -(w0[e] + wacc[nt][e]);
                        const float sp = fmaxf(xs, 0.f) + __logf(1.0f + __expf(-__builtin_fabsf(xs)));
                        ev[i8] = __expf(-sp - 0.5f);
                        const float a = __builtin_amdgcn_rcpf(1.0f + __expf(-(a0[e] + aacc[nt][e])));
                        as[nt][e] = a; kk[nt][e] = k8[i8] * kkw[e]; sskk += kk[nt][e] * kk[nt][e];
                        kh[i8] = k8[i8] * (1.0f + (a - 1.0f) * kaw[e]);
                        bon += r8[i8] * kh[i8] * rkw[e];
                        gg[i8] = gacc[nt][e];
                    }
                }
                if (valid) { const size_t o = (size_t)row * 512 + col;
                    *(u32x4*)(SK + o) = pkh8(kh); *(u32x4*)(SE + o) = pkh8(ev); *(u32x4*)(SV + o) = pkh8(v8); *(u32x4*)(SG + o) = pkh8(gg); }
            }
            sskk += __shfl_xor(sskk, 16); sskk += __shfl_xor(sskk, 32); bon += __shfl_xor(bon, 16); bon += __shfl_xor(bon, 32);
            const float inv = __builtin_amdgcn_rsqf(fmaxf(sskk, 1e-24f));
            if (valid) {
#pragma unroll
                for (int hf = 0; hf < 2; ++hf) { const size_t o = (size_t)row * 512 + col16 + 8 * hf; float kn[8], bb[8];
#pragma unroll
                    for (int i8 = 0; i8 < 8; ++i8) { const int nt = 2 * hf + (i8 >> 2), e = i8 & 3; kn[i8] = kk[nt][e] * inv; bb[i8] = kn[i8] * as[nt][e]; }
                    *(u32x4*)(SKK + o) = pkh8(kn); *(u32x4*)(SB + o) = pkh8(bb); }
                if (fq == 0) BON[(size_t)row * 8 + h] = bon;
            }
        }
    }
}

constexpr int TC = 32, RECB = 1616, SBUF = TC * RECB, YOFF = 2 * SBUF;
struct ScanRegs { u32x2 raw[8]; u32x2 rr[3]; u32x2 rv; };
__device__ __forceinline__ void scan_gload(const Params& P, ScanRegs& R, int b, int h, int rg, int ck, int ll) {
    const unsigned char* ws = P.ws;
    const h16* arr[4] = {(const h16*)(ws + OFF_SE), (const h16*)(ws + OFF_SK), (const h16*)(ws + OFF_SKK), (const h16*)(ws + OFF_SB)};
    const int sub = ll & 15, p = ll >> 4;
#pragma unroll
    for (int i = 0; i < 8; ++i) { const int t = 2 * p + (i & 1), a = i >> 1; int pos = TC * ck + t; pos = pos < LPOS ? pos : LPOS - 1;
        R.raw[i] = *(const u32x2*)(arr[a] + (size_t)rowof(b, pos) * 512 + h * 64 + 4 * sub); }
    { const bf16* PRb = (const bf16*)(ws + OFF_PR);
#pragma unroll
      for (int k = 0; k < 3; ++k) { const int pos = TC * ck + 2 * p - 1 + k; const int pc = pos < 0 ? 0 : (pos < LPOS ? pos : LPOS - 1);
          const u32x2 v = *(const u32x2*)(PRb + (size_t)rowof(b, pc) * 512 + h * 64 + 4 * sub); R.rr[k] = pos < 0 ? (u32x2){0u, 0u} : v; } }
    { const int l2 = ll & 127, t = l2 >> 2, q = l2 & 3; int pos = TC * ck + t; pos = pos < LPOS ? pos : LPOS - 1; R.rv = *(const u32x2*)((const h16*)(ws + OFF_SV) + (size_t)rowof(b, pos) * 512 + h * 64 + 16 * rg + 4 * q); }
}
__device__ __forceinline__ f32x4 h4f(u32x2 r) { const h16x4 hv = __builtin_bit_cast(h16x4, r); return (f32x4){(float)hv[0], (float)hv[1], (float)hv[2], (float)hv[3]}; }
__device__ __forceinline__ f32x4 b4f(u32x2 r) { return (f32x4){__uint_as_float(r.x << 16), __uint_as_float(r.x & 0xffff0000u), __uint_as_float(r.y << 16), __uint_as_float(r.y & 0xffff0000u)}; }
__device__ __forceinline__ void scan_cvt_write(const Params& P, int h, const ScanRegs& R, LAS unsigned char* buf, int ll) {
    const int sub = ll & 15, p = ll >> 4;
    f32x4 f[5][2];
#pragma unroll
    for (int i = 0; i < 8; ++i) f[i >> 1][i & 1] = h4f(R.raw[i]);
    { const f32x4 mu = *(const f32x4*)(P.in[I_MU] + h * 64 + 4 * sub), pm = b4f(R.rr[0]), p0 = b4f(R.rr[1]), p1 = b4f(R.rr[2]); f[4][0] = p0 + (pm - p0) * mu; f[4][1] = p1 + (p0 - p1) * mu; }
#pragma unroll
    for (int st = 0; st < 2; ++st) { f[0][st][0] = __expf(-f[0][st][0]); f[0][st][1] = __expf(-f[0][st][1]); f[0][st][2] = __expf(-f[0][st][2]); f[0][st][3] = __expf(-f[0][st][3]); }
    LAS unsigned char* r0 = buf + (2 * p) * RECB + sub * 16; LAS unsigned char* r1 = r0 + RECB;
#pragma unroll
    for (int a = 0; a < 5; ++a) { *(LAS f32x4*)(r0 + a * 256) = f[a][0]; *(LAS f32x4*)(r1 + a * 256) = f[a][1]; }
    *(LAS f32x4*)(r0 + 1344) = f[0][0] * f[2][1];
    float be = (f[3][0][0] * f[2][1][0] + f[3][0][1] * f[2][1][1]) + (f[3][0][2] * f[2][1][2] + f[3][0][3] * f[2][1][3]);
    float ka = (f[1][0][0] * f[2][1][0] + f[1][0][1] * f[2][1][1]) + (f[1][0][2] * f[2][1][2] + f[1][0][3] * f[2][1][3]);
    be = row16_allsum(be); ka = row16_allsum(ka);
    if (sub == 0) { typedef float f32x2v __attribute__((ext_vector_type(2))); *(LAS f32x2v*)(buf + (2 * p) * RECB + 1600) = (f32x2v){be, ka}; }
    if (ll < 128) { const int t = ll >> 2, q = ll & 3; *(LAS f32x4*)(buf + t * RECB + 1280 + q * 16) = h4f(R.rv); }
}
__device__ __forceinline__ void scan_flush(const Params& P, const LAS unsigned char* yb, int b, int h, int rg, int ck, int ll) {
    if (ll < 128) { const int t = ll >> 2, q = ll & 3, pos = TC * ck + t;
        if (pos >= NMETA && pos < LPOS) { h16* Y = (h16*)(P.ws + OFF_Y); const f32x4 yv = *(const LAS f32x4*)(yb + t * 64 + q * 16); *(u32x2*)(Y + (size_t)(b * SEQ + pos - NMETA) * 512 + h * 64 + 16 * rg + 4 * q) = pkh4(yv[0], yv[1], yv[2], yv[3]); } }
}
#define SC_BAR() do { asm volatile("s_waitcnt lgkmcnt(0)" ::: "memory"); __builtin_amdgcn_s_barrier(); asm volatile("" ::: "memory"); } while (0)
__device__ __forceinline__ float dot4(f32x4 a, f32x4 b) { return __builtin_fmaf(a[3], b[3], __builtin_fmaf(a[2], b[2], __builtin_fmaf(a[1], b[1], a[0] * b[0]))); }
__device__ __forceinline__ void scan_phase(const Params& P, LAS unsigned char* lds, int tid, int wid, int lane) {
    constexpr int NCK = (LPOS + TC - 1) / TC;
    typedef float f32x2v __attribute__((ext_vector_type(2)));
    const int vcu_ = (gridDim.x % 8 == 0) ? ((int)blockIdx.x % 8) * ((int)gridDim.x / 8) + (int)blockIdx.x / 8 : (int)blockIdx.x;
    for (int it = vcu_; it < 256; it += gridDim.x) {
        const int bh = it >> 2, rg = it & 3, b = bh >> 3, h = bh & 7;
        f32x4 S = (f32x4){0.f, 0.f, 0.f, 0.f};
        const int jq = lane & 15, il = 4 * wid + (lane >> 4), ll = tid - 256;
        ScanRegs R;
        SC_BAR();
        if (wid >= 4) { scan_gload(P, R, b, h, rg, 0, ll); scan_cvt_write(P, h, R, lds, ll); scan_gload(P, R, b, h, rg, 1, ll); }
        SC_BAR();
        for (int ck = 0; ck < NCK; ++ck) {
            const int nsteps = (LPOS - TC * ck) < TC ? (LPOS - TC * ck) : TC;
            if (wid >= 4) {
                if (ck + 1 < NCK) { scan_cvt_write(P, h, R, lds + ((ck + 1) & 1) * SBUF, ll); scan_gload(P, R, b, h, rg, ck + 2 < NCK ? ck + 2 : NCK - 1, ll); }
                if (ck > 0) scan_flush(P, lds + YOFF + ((ck - 1) & 1) * 2048, b, h, rg, ck - 1, ll);
            } else {
                const LAS unsigned char* buf = lds + (ck & 1) * SBUF + jq * 16; const LAS unsigned char* vbuf = lds + (ck & 1) * SBUF + 1280 + il * 4; const LAS unsigned char* sbuf = lds + (ck & 1) * SBUF + 1600;
                LAS float* yb = (LAS float*)(lds + YOFF + (ck & 1) * 2048);
                f32x4 w0[2], kh0[2], kk0[2], b0[2], r0[2], wk0[2], w1[2], kh1[2], b1[2], r1[2]; float v0[2], v1[2]; f32x2v bk[2];
#define SC_LOADP(s, t) do { const LAS unsigned char* e_ = buf + (t) * RECB; const LAS unsigned char* o_ = e_ + RECB; \
                    w0[s] = *(const LAS f32x4*)(e_); kh0[s] = *(const LAS f32x4*)(e_ + 256); kk0[s] = *(const LAS f32x4*)(e_ + 512); b0[s] = *(const LAS f32x4*)(e_ + 768); r0[s] = *(const LAS f32x4*)(e_ + 1024); wk0[s] = *(const LAS f32x4*)(e_ + 1344); \
                    w1[s] = *(const LAS f32x4*)(o_); kh1[s] = *(const LAS f32x4*)(o_ + 256); b1[s] = *(const LAS f32x4*)(o_ + 768); r1[s] = *(const LAS f32x4*)(o_ + 1024); \
                    v0[s] = *(const LAS float*)(vbuf + (t) * RECB); v1[s] = *(const LAS float*)(vbuf + (t) * RECB + RECB); bk[s] = *(const LAS f32x2v*)(sbuf + (t) * RECB); } while (0)
                SC_LOADP(0, 0);
                for (int t0 = 0; t0 < nsteps; t0 += 16) {
                    float ykeep = 0.f;
#pragma unroll
                    for (int u = 0; u < 8; ++u) {
                        SC_LOADP((u + 1) & 1, t0 + 2 * u + 2);
                        const int s = u & 1;
                        float dA = dot4(S, kk0[s]), dB = dot4(S, wk0[s]);
                        dA = row16_allsum(dA); dB = row16_allsum(dB);
                        const float sa0 = -dA;
                        const f32x4 S0 = S * w0[s] + (b0[s] * sa0 + kh0[s] * v0[s]);
                        const float sa1 = -(dB + sa0 * bk[s].x + v0[s] * bk[s].y);
                        const f32x4 S1 = S0 * w1[s] + (b1[s] * sa1 + kh1[s] * v1[s]);
                        float y0 = dot4(S0, r0[s]), y1 = dot4(S1, r1[s]);
                        y0 = row16_allsum(y0); y1 = row16_allsum(y1);
                        ykeep = (jq == 2 * u) ? y0 : ykeep; ykeep = (jq == 2 * u + 1) ? y1 : ykeep;
                        S = S1;
                    }
                    yb[(t0 + jq) * 16 + il] = ykeep;
                }
#undef SC_LOADP
            }
            SC_BAR();
        }
        if (wid >= 4) scan_flush(P, lds + YOFF + ((NCK - 1) & 1) * 2048, b, h, rg, NCK - 1, ll);
    }
}

__device__ __forceinline__ void post_phase(const Params& P, int gw, int NGW, int lane) {
    const h16* __restrict__ Y = (const h16*)(P.ws + OFF_Y); const h16* __restrict__ SV = (const h16*)(P.ws + OFF_SV); const h16* __restrict__ SG = (const h16*)(P.ws + OFF_SG); const float* __restrict__ BON = (const float*)(P.ws + OFF_BONUS); bf16* __restrict__ CAT = (bf16*)(P.ws + OFF_RA);
    const int q = lane & 15;
#pragma unroll 4
    for (int g = gw * 4 + (lane >> 4); g < MMAIN * 8; g += NGW * 4) {
        const int row = g >> 3, h = g & 7, col = h * 64 + 4 * q; const size_t o = (size_t)row * 512 + col;
        const f32x4 y = h4f(*(const u32x2*)(Y + o));
        const float mean = row16_allsum((y[0] + y[1]) + (y[2] + y[3])) * (1.0f / 64.0f);
        const f32x4 d = y - mean;
        const float var = row16_allsum((d[0] * d[0] + d[1] * d[1]) + (d[2] * d[2] + d[3] * d[3])) * (1.0f / 64.0f);
        const float rstd = __builtin_amdgcn_rsqf(var + 64e-5f);
        const h16x4 vv = __builtin_bit_cast(h16x4, *(const u32x2*)(SV + o)), gg = __builtin_bit_cast(h16x4, *(const u32x2*)(SG + o));
        const f32x4 lw = *(const f32x4*)(P.in[I_LNW] + col), lb = *(const f32x4*)(P.in[I_LNB] + col); const float bon = BON[(size_t)row * 8 + h];
        float r[4];
#pragma unroll
        for (int e = 0; e < 4; ++e) r[e] = (d[e] * rstd * lw[e] + lb[e] + bon * (float)vv[e]) * (float)gg[e];
        u32x2 w; w.x = pk2(r[0], r[1]); w.y = pk2(r[2], r[3]);
        *(u32x2*)(CAT + (size_t)row * 1024 + 512 + col) = w;
    }
}

#ifndef N_PHASES_PER_LAUNCH
#define N_PHASES_PER_LAUNCH 0
#endif
constexpr int NPHASE = 14;
__global__ void __launch_bounds__(NTHREADS, 2) mega(Params P, int ph_lo, int ph_hi) {
    extern __shared__ __attribute__((aligned(16))) unsigned char lds_raw[];
    LAS unsigned char* lds = (LAS unsigned char*)lds_raw;
    cg::grid_group grid = cg::this_grid();
    const int tid = threadIdx.x, lane = tid & 63, wid = __builtin_amdgcn_readfirstlane(tid >> 6);
    const int G = gridDim.x, gw = blockIdx.x * NWAVES + wid, NGW = G * NWAVES;
    unsigned char* ws = P.ws;
    volatile LAS unsigned* MISC = (volatile LAS unsigned*)(lds + 131072);
    if (tid < 4) MISC[tid] = 0u;
    __syncthreads();
    const XcdBarrier xbar = xcd_barrier_post((unsigned*)(ws + OFF_BAR), MISC);
    if (ph_lo < 0) grid.sync();
#define SEAM(k) do { if ((k) + 1 < ph_hi) xcd_barrier(xbar); } while (0)
#define IN(k) (ph_lo <= (k) && (k) < ph_hi)
#ifndef PROBE_DUP
#define PROBE_DUP 0
#endif
#define REP(k) for (int rep_ = 0; rep_ < 1 + ((PROBE_DUP >> (k)) & 1); ++rep_)
    float* ss1 = (float*)(ws + OFF_SS1); float* ss2 = (float*)(ws + OFF_SS2);
    if (IN(0)) REP(0) { p0_prologue(P, lds, gw, NGW, wid, lane); SEAM(0); }
    if (IN(1)) REP(1) { pg8::Gemm g{(const bf16*)(ws + OFF_RA), (const bf16*)(ws + OFF_WGU1), MMAIN, 2 * DFF, DM}; pg8::StaticOrder S; S.init(MMAIN, 2 * DFF, G, (int)blockIdx.x);
        pg8::EpiSwiGLU E{(bf16*)(ws + OFF_ACT), DFF, nullptr}; pg8::gemm_phase<pg8::EpiSwiGLU, pg8::StaticOrder, true, true>(lds, g, S, E); meta_gu1(P, wid, G, lane); conv_idle(P, lds, 1, (MMAIN / 256) * (2 * DFF / 256), G, wid, lane); SEAM(1); }
    if (IN(2)) { pg8::Gemm g{(const bf16*)(ws + OFF_ACT), (const bf16*)(ws + OFF_WD1), MMAIN, DM, DFF}; pg8::StaticOrder S; S.init(MMAIN, DM, G, (int)blockIdx.x);
        pg8::EpiResid E{nullptr, (const bf16*)(ws + OFF_RA), (const float*)(ws + OFF_RMS0), nullptr, (bf16*)P.out, ss1, 0.5f};     pg8::gemm_phase<pg8::EpiResid, pg8::StaticOrder, true, true>(lds, g, S, E); meta_d1(P, lds, wid, G, lane); SEAM(2); }
    if (IN(4)) REP(4) { pg8::Gemm g{(const bf16*)P.out, (const bf16*)(ws + OFF_WIN), MMAIN, INC, DM}; pg8::StaticOrder S; S.init(MMAIN, INC, G, (int)blockIdx.x);
        pg8::EpiProj E{(bf16*)(ws + OFF_RB), PIECE_E, ss1}; pg8::gemm_phase<pg8::EpiProj, pg8::StaticOrder, true, true>(lds, g, S, E); meta_win(P, wid, G, lane); conv_idle(P, lds, 2, (MMAIN / 256) * (INC / 256), G, wid, lane); SEAM(4); }
    if (IN(5)) { prepA_phase(P, gw, wid, G, NGW, lane); SEAM(5); }
    if (IN(6)) REP(6) { attn_phase(P, lds, tid, wid, lane); SEAM(6); }
    if (IN(7)) REP(7) { prepR_phase(P, wid, G, NGW, lane); SEAM(7); }
    if (IN(8)) REP(8) { scan_phase(P, lds, tid, wid, lane); SEAM(8); }
    if (IN(9)) REP(9) { post_phase(P, gw, NGW, lane); SEAM(9); }
    if (IN(10)) { pg8::Gemm g{(const bf16*)(ws + OFF_RA), (const bf16*)(ws + OFF_WOUT), MMAIN, DM, DM}; pg8::StaticOrder S; S.init(MMAIN, DM, G, (int)blockIdx.x);
        pg8::EpiResid E{nullptr, (const bf16*)P.out, nullptr, nullptr, (bf16*)(ws + OFF_HB2), ss2, 1.0f}; pg8::gemm_phase<pg8::EpiResid, pg8::StaticOrder, true, true>(lds, g, S, E); SEAM(10); }
    if (IN(12)) REP(12) { pg8::Gemm g{(const bf16*)(ws + OFF_HB2), (const bf16*)(ws + OFF_WGU2), MMAIN, 2 * DFF, DM}; pg8::StaticOrder S; S.init(MMAIN, 2 * DFF, G, (int)blockIdx.x);
        pg8::EpiSwiGLU E{(bf16*)(ws + OFF_ACT), DFF, ss2}; pg8::gemm_phase<pg8::EpiSwiGLU, pg8::StaticOrder, true, true>(lds, g, S, E); conv_idle(P, lds, 3, (MMAIN / 256) * (2 * DFF / 256), G, wid, lane); SEAM(12); }
    if (IN(13)) { pg8::Gemm g{(const bf16*)(ws + OFF_ACT), (const bf16*)(ws + OFF_WD2), MMAIN, DM, DFF}; pg8::StaticOrder S; S.init(MMAIN, DM, G, (int)blockIdx.x);
        pg8::EpiResid E{nullptr, (const bf16*)(ws + OFF_HB2), nullptr, P.out, nullptr, nullptr, 0.5f}; pg8::gemm_phase<pg8::EpiResid, pg8::StaticOrder, true, true>(lds, g, S, E); }
#undef SEAM
#undef IN
}

extern "C" void kernel_launch(void* const* d_in, const int* in_sizes, int n_in, void* d_out, int out_size, void* d_ws, size_t ws_size, hipStream_t stream) {
    static int grid = 0;
    if (grid == 0) {
        if (n_in != 28 || out_size != MMAIN * DM || ws_size < WS_END) { fprintf(stderr, "kernel_launch: unexpected shapes (n_in %d out %d ws %zu)\n", n_in, out_size, ws_size); grid = -1; return; }
        int dev = 0, cus = 0, per_cu = 0;
        (void)hipGetDevice(&dev); (void)hipDeviceGetAttribute(&cus, hipDeviceAttributeMultiprocessorCount, dev);
        (void)hipFuncSetAttribute((const void*)mega, hipFuncAttributeMaxDynamicSharedMemorySize, LDS_BYTES);
        (void)hipOccupancyMaxActiveBlocksPerMultiprocessor(&per_cu, (const void*)mega, NTHREADS, LDS_BYTES);
        if (per_cu < 1) { fprintf(stderr, "kernel_launch: occupancy query says %d blocks per CU\n", per_cu); grid = -1; return; }
        grid = cus * (per_cu > 1 ? 1 : per_cu);
    }
    if (grid < 0) return;
    Params p{};
    for (int i = 0; i < 28; ++i) p.in[i] = (const float*)d_in[i];
    p.out = (float*)d_out; p.ws = (unsigned char*)d_ws;
    if (hipMemsetAsync((char*)d_ws + OFF_BAR, 0, 3456 * 4, stream) != hipSuccess) { fprintf(stderr, "kernel_launch: memset of the barrier words failed\n"); return; }
#if N_PHASES_PER_LAUNCH == 0
    int lo = 0, hi = NPHASE; void* args[] = {&p, &lo, &hi};
    hipError_t e = hipLaunchCooperativeKernel((const void*)mega, dim3(grid), dim3(NTHREADS), args, LDS_BYTES, stream);
    if (e != hipSuccess) fprintf(stderr, "cooperative launch failed: %s (grid %d)\n", hipGetErrorString(e), grid);
#else
    for (int k = 0; k < NPHASE; ++k) hipLaunchKernelGGL(mega, dim3(grid), dim3(NTHREADS), LDS_BYTES, stream, p, k, k + 1);
#endif
}
```
